# Optimizing an MI355X kernel written in HIP

```python
import jax, jax.numpy as jnp
from jax import lax
import numpy as np

D_MODEL = 1024
BATCH = 16
SEQ = 2048
DEPTH = 1

GRID_W = 64
Q_BLOCK = 128
ROPE_THETA = 10000.0
EPS = 1e-6
H_A = 8
QK_NOPE = 64
QK_ROPE = 32
V_DIM_A = 64
Q_LORA = 256
KV_LORA = 128
H_B = 8
KV_B = 2
HD_B = 64
D_FF = 4 * D_MODEL
PLE_DIM = 256
IN_SPLITS = [Q_LORA, KV_LORA + QK_ROPE, H_B * HD_B, KV_B * HD_B, KV_B * HD_B, D_MODEL, D_MODEL]
D_IN = sum(IN_SPLITS)

kernel_name = "hybrid_mla_axial_gqa_gated_block"


def rmsnorm(x, g):
    xf = x.astype(jnp.float32)
    y = xf * lax.rsqrt(jnp.mean(xf * xf, axis=-1, keepdims=True) + EPS)
    return (y * g.astype(jnp.float32)).astype(x.dtype)


def rope_angles(pos, dim):
    inv = ROPE_THETA ** (-jnp.arange(0, dim, 2, dtype=jnp.float32) / dim)
    return pos.astype(jnp.float32)[:, None] * inv[None, :]


def apply_rope(x, ang):
    cos = jnp.cos(ang)[None, :, None, :].astype(x.dtype)
    sin = jnp.sin(ang)[None, :, None, :].astype(x.dtype)
    x1, x2 = jnp.split(x, 2, axis=-1)
    return jnp.concatenate([x1 * cos - x2 * sin, x1 * sin + x2 * cos], axis=-1)


def blocked_attention(q, k, v):
    B, S, Hk, G, dk = q.shape
    nb = S // Q_BLOCK
    qb = q.reshape(B, nb, Q_BLOCK, Hk, G, dk).transpose(1, 0, 2, 3, 4, 5)

    def one_block(qblk):
        s = jnp.einsum("bqhgd,bkhd->bhgqk", qblk, k).astype(jnp.float32)
        pr = jax.nn.softmax(s, axis=-1).astype(v.dtype)
        return jnp.einsum("bhgqk,bkhd->bqhgd", pr, v)

    o = lax.map(one_block, qb)
    return o.transpose(1, 0, 2, 3, 4, 5).reshape(B, S, Hk * G, v.shape[-1])


def setup_inputs(seed: int = 0) -> dict:
    key = jax.random.key(seed)
    ks = jax.random.split(key, 24)
    f32 = jnp.float32

    def w(k, shape, fan_in):
        return jax.random.normal(k, shape, f32) * (fan_in ** -0.5)

    def gain(k, shape):
        return 1.0 + 0.05 * jax.random.normal(k, shape, f32)

    L = DEPTH
    return {
        "x": jax.random.normal(ks[0], (BATCH, SEQ, D_MODEL), f32),
        "p": jax.random.normal(ks[1], (DEPTH, BATCH, SEQ, PLE_DIM), f32),
        "g_mix": gain(ks[2], (L, D_MODEL)),
        "w_in": w(ks[3], (L, D_MODEL, D_IN), D_MODEL),
        "g_qa": gain(ks[4], (L, Q_LORA)),
        "w_qb": w(ks[5], (L, Q_LORA, H_A * (QK_NOPE + QK_ROPE)), Q_LORA),
        "g_kva": gain(ks[6], (L, KV_LORA)),
        "w_kvb": w(ks[7], (L, KV_LORA, H_A * (QK_NOPE + V_DIM_A)), KV_LORA),
        "g_qn": gain(ks[8], (L, HD_B)),
        "g_kn": gain(ks[9], (L, HD_B)),
        "w_oa": w(ks[10], (L, H_A * V_DIM_A, D_MODEL), H_A * V_DIM_A),
        "w_ob": w(ks[11], (L, H_B * HD_B, D_MODEL), H_B * HD_B),
        "w_o": w(ks[12], (L, D_MODEL, D_MODEL), D_MODEL),
        "g_mlp": gain(ks[13], (L, D_MODEL)),
        "w_up": w(ks[14], (L, D_MODEL, D_FF), D_MODEL),
        "w_down": w(ks[15], (L, D_FF, D_MODEL), D_FF),
        "g_ple": gain(ks[16], (L, D_MODEL)),
        "w_ple_gate": w(ks[17], (L, D_MODEL, D_MODEL), D_MODEL),
        "w_ple": w(ks[18], (L, PLE_DIM, D_MODEL), PLE_DIM),
        "g_final": gain(ks[19], (D_MODEL,)),
    }


def reference(x, p, g_mix, w_in, g_qa, w_qb, g_kva, w_kvb, g_qn, g_kn, w_oa, w_ob, w_o,
              g_mlp, w_up, w_down, g_ple, w_ple_gate, w_ple, g_final):
    B, S, D = x.shape
    ROWS = S // GRID_W
    t = jnp.arange(S)
    row = jnp.broadcast_to(jnp.arange(ROWS)[:, None], (ROWS, GRID_W)).reshape(-1)
    col = jnp.broadcast_to(jnp.arange(GRID_W)[None, :], (ROWS, GRID_W)).reshape(-1)
    ang_1d = rope_angles(t, QK_ROPE)
    ang_row = rope_angles(row, HD_B // 2)
    ang_col = rope_angles(col, HD_B // 2)
    split_idx = list(np.cumsum(IN_SPLITS)[:-1])
    scale_a = (QK_NOPE + QK_ROPE) ** -0.5
    scale_b = HD_B ** -0.5

    for i in range(DEPTH):
        h = rmsnorm(x, g_mix[i])
        z = jnp.einsum("bsd,de->bse", h, w_in[i])
        q_lat, kv_lat, qb, kb, vb, gate_a, gate_b = jnp.split(z, split_idx, axis=-1)

        cq = rmsnorm(q_lat, g_qa[i])
        qa = jnp.einsum("bsr,re->bse", cq, w_qb[i]).reshape(B, S, H_A, QK_NOPE + QK_ROPE)
        qa_nope, qa_rope = jnp.split(qa, [QK_NOPE], axis=-1)
        qa_rope = apply_rope(qa_rope, ang_1d)
        c_kv, k_pe = jnp.split(kv_lat, [KV_LORA], axis=-1)
        c_kv = rmsnorm(c_kv, g_kva[i])
        k_pe = apply_rope(k_pe[:, :, None, :], ang_1d)
        kva = jnp.einsum("bsr,re->bse", c_kv, w_kvb[i]).reshape(B, S, H_A, QK_NOPE + V_DIM_A)
        ka_nope, va = jnp.split(kva, [QK_NOPE], axis=-1)
        qa_full = (jnp.concatenate([qa_nope, qa_rope], axis=-1) * scale_a)[:, :, :, None, :]
        ka_full = jnp.concatenate([ka_nope, jnp.broadcast_to(k_pe, (B, S, H_A, QK_ROPE))], axis=-1)
        oa = blocked_attention(qa_full, ka_full, va).reshape(B, S, H_A * V_DIM_A)
        ya = jnp.einsum("bse,ed->bsd", oa, w_oa[i])

        qb = rmsnorm(qb.reshape(B, S, H_B, HD_B), g_qn[i])
        kb = rmsnorm(kb.reshape(B, S, KV_B, HD_B), g_kn[i])
        vb = vb.reshape(B, S, KV_B, HD_B)
        qr, qc = jnp.split(qb, 2, axis=-1)
        qb = jnp.concatenate([apply_rope(qr, ang_row), apply_rope(qc, ang_col)], axis=-1)
        kr, kc = jnp.split(kb, 2, axis=-1)
        kb = jnp.concatenate([apply_rope(kr, ang_row), apply_rope(kc, ang_col)], axis=-1)
        qb = (qb * scale_b).reshape(B, S, KV_B, H_B // KV_B, HD_B)
        ob = blocked_attention(qb, kb, vb).reshape(B, S, H_B * HD_B)
        yb = jnp.einsum("bse,ed->bsd", ob, w_ob[i])

        merged = jax.nn.sigmoid(gate_a) * ya + jax.nn.sigmoid(gate_b) * yb
        x = x + jnp.einsum("bsd,de->bse", merged, w_o[i])

        h2 = rmsnorm(x, g_mlp[i])
        u = jax.nn.relu(jnp.einsum("bsd,df->bsf", h2, w_up[i]))
        x = x + jnp.einsum("bsf,fd->bsd", u * u, w_down[i])

        h3 = rmsnorm(x, g_ple[i])
        gate = jax.nn.sigmoid(jnp.einsum("bsd,de->bse", h3, w_ple_gate[i]))
        x = x + gate * jnp.einsum("bsk,kd->bsd", p[i], w_ple[i])

    return rmsnorm(x, g_final)
```

```cpp
#include <hip/hip_runtime.h>
#include <hip/hip_cooperative_groups.h>
#include <cstdio>
#include <cstdint>
#include <cmath>

#define GAS __attribute__((address_space(1)))
#define LAS __attribute__((address_space(3)))
typedef unsigned short bf16_t;
typedef short bf16x8 __attribute__((ext_vector_type(8)));
typedef short s16x4 __attribute__((ext_vector_type(4)));
typedef float f32x2 __attribute__((ext_vector_type(2)));
typedef float f32x4 __attribute__((ext_vector_type(4)));
typedef float f32x16 __attribute__((ext_vector_type(16)));
typedef unsigned u32x2 __attribute__((ext_vector_type(2)));
typedef unsigned u32x4 __attribute__((ext_vector_type(4)));

constexpr int BATCH = 16, SEQ = 2048, T = BATCH * SEQ, D = 1024, FF = 4096, PLE = 256;
constexpr int DIN = 3232, NIN = 3328;
constexpr float EPS = 1e-6f;
constexpr float LOG2E = 1.4426950408889634f;
constexpr float SCALE_A = 0.10206207261596577f * LOG2E;
constexpr float SCALE_B = 0.125f * LOG2E;

constexpr size_t MiB = 1u << 20;
constexpr size_t WS_CTL = 0, CTL_ZERO_BYTES = 1 * MiB;
constexpr size_t WS_TAB = 1 * MiB;
constexpr size_t WS_SSQ = WS_TAB + 512 * 1024;
constexpr size_t WS_SSKV = 2 * MiB;
constexpr size_t WS_SS1 = 3 * MiB, WS_SS2 = 5 * MiB, WS_SS3 = 7 * MiB;
constexpr size_t WS_WIN = 10 * MiB, WS_WQB = 17 * MiB, WS_WKVB = 17 * MiB + 512 * 1024, WS_WOA = 18 * MiB, WS_WOB = 19 * MiB, WS_WO = 20 * MiB,
                 WS_WUP = 22 * MiB, WS_WDN = 30 * MiB, WS_WPG = 38 * MiB, WS_WPLE = 40 * MiB;
constexpr size_t WS_PP = 48 * MiB;
constexpr size_t WS_XG = 112 * MiB;
constexpr size_t WS_OA = 112 * MiB, WS_OB = 144 * MiB;
constexpr size_t WS_U = 176 * MiB;
constexpr size_t WS_GATES = 176 * MiB;
constexpr size_t WS_QA = 304 * MiB;
constexpr size_t WS_PB = 304 * MiB;
constexpr size_t WS_MG = 304 * MiB;
constexpr size_t WS_KAN = 352 * MiB, WS_VA = 384 * MiB;
constexpr size_t WS_QB = 416 * MiB;
constexpr size_t WS_KB = 448 * MiB, WS_VB = 456 * MiB;
constexpr size_t WS_KPE = 464 * MiB;
constexpr size_t WS_QL = 466 * MiB, WS_KVL = 482 * MiB;
constexpr size_t WS_END = 498 * MiB;

constexpr int CW_BAR = 4096;

typedef __bf16 bf16x2_t __attribute__((ext_vector_type(2)));
__device__ __forceinline__ unsigned cvt_pk_bf16(float lo, float hi) { f32x2 v = {lo, hi}; bf16x2_t b = __builtin_convertvector(v, bf16x2_t); return __builtin_bit_cast(unsigned, b); }
__device__ __forceinline__ u32x4 pack8(f32x4 a, f32x4 b) { u32x4 w; w.x = cvt_pk_bf16(a[0], a[1]); w.y = cvt_pk_bf16(a[2], a[3]); w.z = cvt_pk_bf16(b[0], b[1]); w.w = cvt_pk_bf16(b[2], b[3]); return w; }
__device__ __forceinline__ u32x2 pack4(f32x4 a) { u32x2 w; w.x = cvt_pk_bf16(a[0], a[1]); w.y = cvt_pk_bf16(a[2], a[3]); return w; }
__device__ __forceinline__ void unpack8(u32x4 w, f32x4& a, f32x4& b) {
    a[0] = __uint_as_float(w.x << 16); a[1] = __uint_as_float(w.x & 0xffff0000u); a[2] = __uint_as_float(w.y << 16); a[3] = __uint_as_float(w.y & 0xffff0000u);
    b[0] = __uint_as_float(w.z << 16); b[1] = __uint_as_float(w.z & 0xffff0000u); b[2] = __uint_as_float(w.w << 16); b[3] = __uint_as_float(w.w & 0xffff0000u); }
__device__ __forceinline__ float sigmoidf_(float x) { return __builtin_amdgcn_rcpf(1.0f + __builtin_amdgcn_exp2f(-LOG2E * x)); }
__device__ __forceinline__ f32x4 sigmoid4(f32x4 v) { f32x4 o; o[0] = sigmoidf_(v[0]); o[1] = sigmoidf_(v[1]); o[2] = sigmoidf_(v[2]); o[3] = sigmoidf_(v[3]); return o; }
__device__ __forceinline__ float sumsq4(f32x4 v) { return (v[0] * v[0] + v[1] * v[1]) + (v[2] * v[2] + v[3] * v[3]); }
__device__ __forceinline__ float rsqrt_(float v) { return 1.0f / sqrtf(v); }
__device__ __forceinline__ float red4x(float s) { s += __shfl_xor(s, 16); s += __shfl_xor(s, 32); return s; }
#define XB_TMO      128
#define XB_XCNT(j)  (256  + 64 * (j))
#define XB_XSUB(j)  (1280 + 64 * (j))
#define XB_XGEN(j)  (2304 + 64 * (j))
#define XB_TOP      3328
#define XB_TOPGEN   3392
#define XCD_BAR_WORDS 3456
#define XB_SPIN_CAP (1u << 18)

__device__ __forceinline__ unsigned xb_ld(unsigned* p)              { return __hip_atomic_load(p, __ATOMIC_RELAXED, __HIP_MEMORY_SCOPE_AGENT); }
__device__ __forceinline__ unsigned xb_add(unsigned* p, unsigned v) { return __hip_atomic_fetch_add(p, v, __ATOMIC_RELAXED, __HIP_MEMORY_SCOPE_AGENT); }
__device__ __forceinline__ unsigned xb_xcc_id() { return (unsigned)__builtin_amdgcn_s_getreg((3 << 11) | 20) & 0xFu; }
#define XB_SPIN(cond, bar) do { unsigned _sp = 0; while (cond) { __builtin_amdgcn_s_sleep(1); \
    if ((++_sp & 255u) == 0u) { if (xb_ld(&(bar)[XB_TMO])) break; if (_sp > XB_SPIN_CAP) { atomicAdd(&(bar)[XB_TMO], 1u); break; } } } } while (0)

struct XcdBarrier { unsigned* bar; unsigned x; volatile LAS unsigned* st; };

__device__ __forceinline__ XcdBarrier xcd_barrier_post(unsigned* bar, volatile LAS unsigned* st) {
    XcdBarrier b; b.bar = bar; b.x = xb_xcc_id(); b.st = st;
    if (threadIdx.x == 0) (void)xb_add(&bar[XB_XCNT(b.x)], 1u);
    return b;
}
__device__ __forceinline__ void xcd_barrier_complete(unsigned* bar, unsigned x, unsigned& nloc, unsigned& nx) {
    const unsigned G = gridDim.x * gridDim.y * gridDim.z;
    unsigned sum, cnt, mine, sp = 0u;
    for (;;) {
        sum = 0u; cnt = 0u; mine = 0u;
#pragma unroll
        for (unsigned j = 0; j < 16; ++j) { const unsigned c = xb_ld(&bar[XB_XCNT(j)]); sum += c; cnt += (c > 0u) ? 1u : 0u; mine = (j == x) ? c : mine; }
        if (sum == G) break;
        __builtin_amdgcn_s_sleep(1);
        if ((++sp & 255u) == 0u) { if (xb_ld(&bar[XB_TMO])) break; if (sp > XB_SPIN_CAP) { atomicAdd(&bar[XB_TMO], 1u); break; } }
    }
    nloc = mine > 0u ? mine : 1u; nx = cnt > 0u ? cnt : 1u;
}
__device__ __forceinline__ void xcd_barrier(const XcdBarrier& b) {
    asm volatile("s_waitcnt vmcnt(0)" ::: "memory");
    __syncthreads();
    if (threadIdx.x == 0) {
        unsigned* bar = b.bar;
        __builtin_amdgcn_s_waitcnt(0);
        unsigned nloc = b.st[0], nx = b.st[1];
        if (nloc == 0u) { xcd_barrier_complete(bar, b.x, nloc, nx); b.st[0] = nloc; b.st[1] = nx; }
        const unsigned old = xb_add(&bar[XB_XSUB(b.x)], 1u);
        const unsigned gen = old / nloc;
        if (old + 1u == (gen + 1u) * nloc) {
            __builtin_amdgcn_fence(__ATOMIC_RELEASE, "agent");
            asm volatile("s_waitcnt vmcnt(0)" ::: "memory");
            const unsigned og = xb_add(&bar[XB_TOP], 1u);
            const unsigned tg = og / nx;
            if (og + 1u == (tg + 1u) * nx) xb_add(&bar[XB_TOPGEN], 1u);
            else XB_SPIN(xb_ld(&bar[XB_TOPGEN]) == tg, bar);
            __builtin_amdgcn_fence(__ATOMIC_ACQUIRE, "agent");
            xb_add(&bar[XB_XGEN(b.x)], 1u);
            asm volatile("s_waitcnt vmcnt(0)" ::: "memory");
        } else {
            XB_SPIN(xb_ld(&bar[XB_XGEN(b.x)]) == gen, bar);
            __builtin_amdgcn_fence(__ATOMIC_ACQUIRE, "agent");
            asm volatile("s_waitcnt vmcnt(0)" ::: "memory");
        }
    }
    __syncthreads();
}


namespace pg8 {
#define PG8_LAS __attribute__((address_space(3)))
constexpr int BM = 256, BK = 64, HALF = 128, HTB = HALF * BK * 2  , STAGE_BYTES = 8 * HTB, NXCD = 8, WGM = 8;

__host__ __device__ __forceinline__ int lds_byte(int r, int c) { const int st = (r >> 4) * 2 + (c >> 5), rr = r & 15, cc = c & 31, ob = rr * 64 + cc * 2; return st * 1024 + (ob ^ (((ob >> 9) & 1) << 5)); }
__host__ __device__ __forceinline__ void stage_rc(int b, int& R, int& C) { const int st = b / 1024, sb = b % 1024, swz = sb ^ (((sb >> 9) & 1) << 5); R = (st >> 1) * 16 + swz / 64; C = (st & 1) * 32 + (swz % 64) / 2; }
__host__ __device__ __forceinline__ int perm32(int rho) { const int n = rho >> 4, i = rho & 15; return 8 * (i >> 2) + 4 * n + (i & 3); }


struct Unit { int pm, pn, sel, pnb; };
struct Gemm { const bf16_t* A0; const bf16_t* A1; const bf16_t* B0; const bf16_t* B1; int K; };

template <int MODE> struct Order {
    int nM, nN, nwg, G, c;
    __device__ void init(int M, int N, int G_, int c_) { nM = M / BM; nN = N / BM; nwg = nM * nN; G = G_; c = c_; }
    __device__ bool next(int i, Unit& u) const {
        const int ii = (MODE == 2) ? (i >> 1) : i;
        const long L = (long)ii * G + c; if (L >= nwg) return false;
        int wgid = (int)L; { const int q = nwg / NXCD, r = nwg % NXCD, xcd = wgid % NXCD, off = wgid / NXCD; wgid = (xcd < r ? xcd * (q + 1) : r * (q + 1) + (xcd - r) * q) + off; }
        const int nig = WGM * nN, gid = wgid / nig, fm = gid * WGM, gsz = (nM - fm) < WGM ? (nM - fm) : WGM;
        u.pm = fm + ((wgid % nig) % gsz); u.pn = (wgid % nig) / gsz;
        if (MODE == 0) { u.sel = 0; u.pnb = u.pn; }
        else if (MODE == 1) { u.sel = (u.pn >= 3) ? 1 : 0; u.pnb = u.sel ? u.pn - 3 : u.pn; }
        else { u.sel = i & 1; u.pnb = u.pn; }
        return true;
    }
};
template <class Epi, class Sched, bool ALIGN_EPI = true, bool SP2 = true>
__device__ __forceinline__ void gemm_phase(PG8_LAS unsigned char* lds, const Gemm g, const Sched& S, const Epi& E) {
    int tid_ = threadIdx.x; asm volatile("" : "+v"(tid_));
    const int tid = tid_, wid = __builtin_amdgcn_readfirstlane(tid >> 6), lane = tid & 63, wr = wid >> 2, wc = wid & 3, fr = lane & 15, fq = lane >> 4;
    const int K = g.K, nt = K / BK;
    unsigned voffA[2], voffB[2];
#pragma unroll
    for (int i = 0; i < 2; ++i) { int R, C; stage_rc(tid * 16 + i * 8192, R, C); const int Rb = Epi::PERM ? ((R & ~31) + perm32(R & 31)) : R;
        voffA[i] = (unsigned)(R * K + C) * 2u; voffB[i] = (unsigned)(Rb * K + C) * 2u; }
    const size_t kstep = (size_t)(BK * 2);
    const size_t hstep = (size_t)HALF * K * 2;
    const size_t tstep = 2 * hstep;
    const unsigned ldsw = (unsigned)wid * 1024u;
    const int aoff = lds_byte(wr * 64 + fr, fq * 8), boff = lds_byte(wc * 32 + fr, fq * 8);
#define PG8_SA(b, h) (((b) * 2 + (h)) * HTB)
#define PG8_SB(b, h) ((4 + (b) * 2 + (h)) * HTB)
#define PG8_STAGE(bufoff, gbase, voff) do { _Pragma("unroll") for (int _i = 0; _i < 2; ++_i) \
        __builtin_amdgcn_global_load_lds((const unsigned*)((const char*)(gbase) + (voff)[_i]), (PG8_LAS unsigned*)(lds + (bufoff) + ldsw + _i * 8192), 16, 0, 0); } while (0)
#define PG8_LDA(dst, b, h) do { _Pragma("unroll") for (int m = 0; m < 4; ++m) _Pragma("unroll") for (int k = 0; k < 2; ++k) dst[m][k] = *(const PG8_LAS bf16x8*)(lds + PG8_SA(b, h) + aoff + m * 2048 + k * 1024); } while (0)
#define PG8_LDB(dst, b, h) do { _Pragma("unroll") for (int n = 0; n < 2; ++n) _Pragma("unroll") for (int k = 0; k < 2; ++k) dst[n][k] = *(const PG8_LAS bf16x8*)(lds + PG8_SB(b, h) + boff + n * 2048 + k * 1024); } while (0)
#define PG8_MMA(ai, bj, At, Bt) do { __builtin_amdgcn_s_setprio(1); _Pragma("unroll") for (int m = 0; m < 4; ++m) _Pragma("unroll") for (int n = 0; n < 2; ++n) _Pragma("unroll") for (int k = 0; k < 2; ++k) \
        acc[ai][bj][m][n] = __builtin_amdgcn_mfma_f32_16x16x32_bf16(Bt[n][k], At[m][k], acc[ai][bj][m][n], 0, 0, 0); __builtin_amdgcn_s_setprio(0); } while (0)
#define PG8_WAIT_V(n) asm volatile("s_waitcnt vmcnt(" #n ")" ::: "memory")
#define PG8_WAIT_L(n) asm volatile("s_waitcnt lgkmcnt(" #n ")" ::: "memory")
#define PG8_BAR __builtin_amdgcn_s_barrier()
#define PG8_SCHED __builtin_amdgcn_sched_barrier(0)
    Unit cur, nxt; int ui = 0;
    if (!S.next(0, cur)) return;
    f32x4 acc[2][2][4][2];
#pragma unroll
    for (int a = 0; a < 2; ++a)
#pragma unroll
        for (int b = 0; b < 2; ++b)
#pragma unroll
            for (int m = 0; m < 4; ++m)
#pragma unroll
                for (int n = 0; n < 2; ++n) acc[a][b][m][n] = (f32x4){0.f, 0.f, 0.f, 0.f};
    bf16x8 At[4][2], B0[2][2], B1[2][2];
    const char* cA = (const char*)(cur.sel ? g.A1 : g.A0) + (size_t)cur.pm * tstep; const char* cB = (const char*)(cur.sel ? g.B1 : g.B0) + (size_t)cur.pnb * tstep;
    if constexpr (SP2) {
        PG8_STAGE(PG8_SB(0, 0), cB, voffB); PG8_STAGE(PG8_SB(0, 1), cB + hstep, voffB); PG8_STAGE(PG8_SA(0, 0), cA, voffA); PG8_STAGE(PG8_SA(0, 1), cA + hstep, voffA);
        if (wr == 1) PG8_BAR;
        PG8_WAIT_V(2); PG8_BAR;
        PG8_STAGE(PG8_SB(1, 0), cB + kstep, voffB); PG8_STAGE(PG8_SA(1, 0), cA + kstep, voffA); PG8_STAGE(PG8_SB(1, 1), cB + hstep + kstep, voffB);
        PG8_WAIT_V(6); PG8_BAR;
    } else {
        PG8_STAGE(PG8_SB(0, 0), cB, voffB); PG8_STAGE(PG8_SA(0, 0), cA, voffA); PG8_STAGE(PG8_SB(0, 1), cB + hstep, voffB); PG8_STAGE(PG8_SA(0, 1), cA + hstep, voffA);
        if (wr == 1) PG8_BAR;
        PG8_WAIT_V(4); PG8_BAR;
        PG8_STAGE(PG8_SB(1, 0), cB + kstep, voffB); PG8_STAGE(PG8_SA(1, 0), cA + kstep, voffA); PG8_STAGE(PG8_SB(1, 1), cB + hstep + kstep, voffB);
        PG8_WAIT_V(6); PG8_BAR;
    }
    for (;;) {
        const bool has_next = S.next(ui + 1, nxt);
        const char* nA = has_next ? (const char*)(nxt.sel ? g.A1 : g.A0) + (size_t)nxt.pm * tstep : cA; const char* nB = has_next ? (const char*)(nxt.sel ? g.B1 : g.B0) + (size_t)nxt.pnb * tstep : cB;
        for (int t = 0; t < nt; t += 2) {
            const bool last = (t == nt - 2);
            const char* a1 = cA + (size_t)(t + 1) * kstep;
            const char* a2 = last ? nA : cA + (size_t)(t + 2) * kstep; const char* b2 = last ? nB : cB + (size_t)(t + 2) * kstep;
            const char* a3 = a2 + kstep; const char* b3 = b2 + kstep;
            if constexpr (SP2) {
            PG8_LDB(B0, 0, 0); PG8_LDB(B1, 0, 1); PG8_SCHED; PG8_LDA(At, 0, 0); PG8_STAGE(PG8_SA(1, 1), a1 + hstep, voffA);
            PG8_WAIT_V(8); PG8_WAIT_L(0); PG8_BAR; PG8_MMA(0, 0, At, B0); PG8_MMA(0, 1, At, B1); PG8_BAR; PG8_SCHED;
            PG8_LDA(At, 0, 1); PG8_STAGE(PG8_SB(0, 0), b2, voffB); PG8_STAGE(PG8_SB(0, 1), b2 + hstep, voffB); PG8_STAGE(PG8_SA(0, 0), a2, voffA);
            PG8_WAIT_V(8); PG8_WAIT_L(0); PG8_BAR; PG8_MMA(1, 0, At, B0); PG8_MMA(1, 1, At, B1); PG8_BAR; PG8_SCHED;
            PG8_LDB(B0, 1, 0); PG8_LDB(B1, 1, 1); PG8_SCHED; PG8_LDA(At, 1, 0); PG8_STAGE(PG8_SA(0, 1), a2 + hstep, voffA);
            PG8_WAIT_V(8); PG8_WAIT_L(0); PG8_BAR; PG8_MMA(0, 0, At, B0); PG8_MMA(0, 1, At, B1); PG8_BAR; PG8_SCHED;
            PG8_LDA(At, 1, 1); PG8_STAGE(PG8_SB(1, 0), b3, voffB); PG8_STAGE(PG8_SB(1, 1), b3 + hstep, voffB); PG8_STAGE(PG8_SA(1, 0), a3, voffA);
            PG8_WAIT_V(8); PG8_WAIT_L(0); PG8_BAR; PG8_MMA(1, 0, At, B0); PG8_MMA(1, 1, At, B1); PG8_BAR; PG8_SCHED;
            } else {
            PG8_LDB(B0, 0, 0); PG8_SCHED; PG8_LDA(At, 0, 0); PG8_STAGE(PG8_SA(1, 1), a1 + hstep, voffA);
            PG8_WAIT_L(8); PG8_BAR; PG8_WAIT_L(0); PG8_MMA(0, 0, At, B0); PG8_BAR; PG8_SCHED;
            PG8_LDB(B1, 0, 1); PG8_STAGE(PG8_SB(0, 0), b2, voffB);
            PG8_BAR; PG8_WAIT_L(0); PG8_MMA(0, 1, At, B1); PG8_BAR;
            PG8_LDA(At, 0, 1); PG8_STAGE(PG8_SA(0, 0), a2, voffA);
            PG8_BAR; PG8_WAIT_L(0); PG8_MMA(1, 0, At, B0); PG8_BAR; PG8_SCHED;
            PG8_STAGE(PG8_SB(0, 1), b2 + hstep, voffB);
            PG8_WAIT_V(6); PG8_BAR; PG8_MMA(1, 1, At, B1); PG8_BAR;
            PG8_LDB(B0, 1, 0); PG8_SCHED; PG8_LDA(At, 1, 0); PG8_STAGE(PG8_SA(0, 1), a2 + hstep, voffA);
            PG8_WAIT_L(8); PG8_BAR; PG8_WAIT_L(0); PG8_MMA(0, 0, At, B0); PG8_BAR; PG8_SCHED;
            PG8_LDB(B1, 1, 1); PG8_STAGE(PG8_SB(1, 0), b3, voffB);
            PG8_BAR; PG8_WAIT_L(0); PG8_MMA(0, 1, At, B1); PG8_BAR;
            PG8_LDA(At, 1, 1); PG8_STAGE(PG8_SA(1, 0), a3, voffA);
            PG8_BAR; PG8_WAIT_L(0); PG8_MMA(1, 0, At, B0); PG8_BAR; PG8_SCHED;
            PG8_STAGE(PG8_SB(1, 1), b3 + hstep, voffB);
            PG8_WAIT_V(6); PG8_BAR; PG8_MMA(1, 1, At, B1); PG8_BAR;
            }
        }
        if constexpr (ALIGN_EPI) { if (wr == 0) PG8_BAR; }
        const bool keep = E.keep(cur);
        if (keep) E.mid(acc, cur, wr, wc, fr, fq); else E(acc, cur, wr, wc, fr, fq);
        if (!has_next) break;
        if (!keep)
#pragma unroll
        for (int a = 0; a < 2; ++a)
#pragma unroll
            for (int b = 0; b < 2; ++b)
#pragma unroll
                for (int m = 0; m < 4; ++m)
#pragma unroll
                    for (int n = 0; n < 2; ++n) acc[a][b][m][n] = (f32x4){0.f, 0.f, 0.f, 0.f};
        cur = nxt; cA = nA; cB = nB; ++ui;
        if constexpr (ALIGN_EPI) { if (wr == 1) PG8_BAR; }
    }
    PG8_WAIT_V(0);
    if constexpr (!ALIGN_EPI) { if (wr == 0) PG8_BAR; }
    PG8_BAR;
#undef PG8_SA
#undef PG8_SB
#undef PG8_STAGE
#undef PG8_LDA
#undef PG8_LDB
#undef PG8_MMA
#undef PG8_WAIT_V
#undef PG8_WAIT_L
#undef PG8_BAR
#undef PG8_SCHED
}

#define EPI_COMMON static constexpr bool PERM = false, AFTER_DRAIN = false; \
    __device__ __forceinline__ bool keep(const Unit&) const { return false; } \
    __device__ __forceinline__ void mid(f32x4 (&)[2][2][4][2], const Unit&, int, int, int, int) const {}
typedef const f32x4 (&AccRef)[2][2][4][2];

__device__ __forceinline__ void rope4(const f32x2* tabrow, int fq, f32x4 x1, f32x4 x2, f32x4& o1, f32x4& o2) {
    const f32x4 t0 = *(const f32x4*)(tabrow + 4 * fq), t1 = *(const f32x4*)(tabrow + 4 * fq + 2);
    o1[0] = x1[0] * t0[0] - x2[0] * t0[1]; o2[0] = x1[0] * t0[1] + x2[0] * t0[0];
    o1[1] = x1[1] * t0[2] - x2[1] * t0[3]; o2[1] = x1[1] * t0[3] + x2[1] * t0[2];
    o1[2] = x1[2] * t1[0] - x2[2] * t1[1]; o2[2] = x1[2] * t1[1] + x2[2] * t1[0];
    o1[3] = x1[3] * t1[2] - x2[3] * t1[3]; o2[3] = x1[3] * t1[3] + x2[3] * t1[2];
}

struct EpiIn {
    EPI_COMMON
    bf16_t *QL, *KVL, *KPE, *QB, *KB, *VB, *GATES; float *SSQ, *SSKV; const f32x2* TAB; const float *gqn, *gkn;
    __device__ __forceinline__ void operator()(AccRef acc, const Unit& u, int wr, int wc, int fr, int fq) const {
        const int pn = u.pn, row0 = u.pm * BM + wr * 64 + fr;
        if (pn >= 5) {
#pragma unroll
            for (int ai = 0; ai < 2; ++ai)
#pragma unroll
                for (int m = 0; m < 4; ++m) { bf16_t* rowp = GATES + (size_t)(row0 + ai * HALF + m * 16) * 2048 + (pn - 5) * 256 + wc * 32 + 8 * fq;
#pragma unroll
                    for (int bj = 0; bj < 2; ++bj) *(u32x4*)(rowp + bj * HALF) = pack8(sigmoid4(acc[ai][bj][m][0]), sigmoid4(acc[ai][bj][m][1]));  asm volatile("" ::: "memory"); }
        } else if (pn == 0) {
#pragma unroll
            for (int ai = 0; ai < 2; ++ai)
#pragma unroll
                for (int m = 0; m < 4; ++m) { const int row = row0 + ai * HALF + m * 16; bf16_t* rowp = QL + (size_t)row * 256 + wc * 32 + 8 * fq; float ss = 0.f;
#pragma unroll
                    for (int bj = 0; bj < 2; ++bj) { const f32x4 v0 = acc[ai][bj][m][0], v1 = acc[ai][bj][m][1]; ss += sumsq4(v0) + sumsq4(v1); *(u32x4*)(rowp + bj * HALF) = pack8(v0, v1); }
                    ss = red4x(ss); if (fq == 0) SSQ[(size_t)row * 4 + wc] = ss;  asm volatile("" ::: "memory"); }
        } else if (pn == 1) {
#pragma unroll
            for (int ai = 0; ai < 2; ++ai)
#pragma unroll
                for (int m = 0; m < 4; ++m) { const int row = row0 + ai * HALF + m * 16; bf16_t* rowp = KVL + (size_t)row * 256;
                    { const f32x4 v0 = acc[ai][0][m][0], v1 = acc[ai][0][m][1]; float ss = red4x(sumsq4(v0) + sumsq4(v1)); *(u32x4*)(rowp + wc * 32 + 8 * fq) = pack8(v0, v1); if (fq == 0) SSKV[(size_t)row * 4 + wc] = ss; }
                    const f32x4 x1 = acc[ai][1][m][0], x2 = acc[ai][1][m][1];
                    if (wc == 0) {
                        *(u32x2*)(rowp + 128 + 4 * fq) = pack4(x1); *(u32x2*)(rowp + 128 + 16 + 4 * fq) = pack4(x2);
                        f32x4 o1, o2; rope4(TAB + (size_t)(row & (SEQ - 1)) * 16, fq, x1, x2, o1, o2);
                        *(u32x2*)(KPE + (size_t)row * 32 + 4 * fq) = pack4(o1); *(u32x2*)(KPE + (size_t)row * 32 + 16 + 4 * fq) = pack4(o2);
                    } else *(u32x4*)(rowp + 128 + wc * 32 + 8 * fq) = pack8(x1, x2);
                    asm volatile("" ::: "memory"); }
        } else {
            const bool isv = (pn == 4) && (wc >= 2);
            if (isv) {
#pragma unroll
                for (int ai = 0; ai < 2; ++ai)
#pragma unroll
                    for (int m = 0; m < 4; ++m) { bf16_t* rowp = VB + (size_t)(row0 + ai * HALF + m * 16) * 128 + (wc - 2) * 64 + 4 * fq;
#pragma unroll
                        for (int bj = 0; bj < 2; ++bj)
#pragma unroll
                            for (int n = 0; n < 2; ++n) *(u32x2*)(rowp + 32 * bj + 16 * n) = pack4(acc[ai][bj][m][n]);  asm volatile("" ::: "memory"); }
            } else {
                const bool isk = (pn == 4); const float* g = isk ? gkn : gqn; const float osc = isk ? 1.0f : SCALE_B;
                f32x4 gv[2][2];
#pragma unroll
                for (int bj = 0; bj < 2; ++bj)
#pragma unroll
                    for (int n = 0; n < 2; ++n) gv[bj][n] = *(const f32x4*)(g + 32 * bj + 16 * n + 4 * fq);
#pragma unroll
                for (int ai = 0; ai < 2; ++ai)
#pragma unroll
                    for (int m = 0; m < 4; ++m) { const int row = row0 + ai * HALF + m * 16, t = row & (SEQ - 1);
                        bf16_t* rowp = isk ? KB + (size_t)row * 128 + wc * 64 + 4 * fq : QB + (size_t)row * 512 + (4 * (pn - 2) + wc) * 64 + 4 * fq;
                        float ss = 0.f;
#pragma unroll
                        for (int bj = 0; bj < 2; ++bj) ss += sumsq4(acc[ai][bj][m][0]) + sumsq4(acc[ai][bj][m][1]);
                        const float rs = rsqrt_(red4x(ss) * (1.0f / 64.0f) + EPS);
#pragma unroll
                        for (int bj = 0; bj < 2; ++bj) { const int pos = bj == 0 ? (t >> 6) : (t & 63);
                            f32x4 o1, o2; rope4(TAB + (size_t)pos * 16, fq, acc[ai][bj][m][0] * rs * gv[bj][0], acc[ai][bj][m][1] * rs * gv[bj][1], o1, o2);
                            *(u32x2*)(rowp + 32 * bj) = pack4(o1 * osc); *(u32x2*)(rowp + 32 * bj + 16) = pack4(o2 * osc); }  asm volatile("" ::: "memory"); }
            }
        }
    }
};

struct EpiPle {
    EPI_COMMON
    bf16_t* PP;
    __device__ __forceinline__ void operator()(AccRef acc, const Unit& u, int wr, int wc, int fr, int fq) const {
        const int row0 = u.pm * BM + wr * 64 + fr, col0 = u.pn * BM + wc * 32 + 8 * fq;
#pragma unroll
        for (int ai = 0; ai < 2; ++ai)
#pragma unroll
            for (int m = 0; m < 4; ++m) { bf16_t* rowp = PP + (size_t)(row0 + ai * HALF + m * 16) * D + col0;
#pragma unroll
                for (int bj = 0; bj < 2; ++bj) *(u32x4*)(rowp + bj * HALF) = pack8(acc[ai][bj][m][0], acc[ai][bj][m][1]); }
    }
};

struct EpiLat {
    EPI_COMMON
    bf16_t *QA, *KAN, *VA; const float *SSQ, *SSKV; const f32x2* TAB;
    __device__ __forceinline__ void operator()(AccRef acc, const Unit& u, int wr, int wc, int fr, int fq) const {
        const int pn = u.pn, row0 = u.pm * BM + wr * 64 + fr;
#pragma unroll
        for (int ai = 0; ai < 2; ++ai)
#pragma unroll
            for (int m = 0; m < 4; ++m) { const int row = row0 + ai * HALF + m * 16;
                if (pn < 3) {
                    const f32x4 s4 = *(const f32x4*)(SSQ + (size_t)row * 4); const float rs = rsqrt_(((s4[0] + s4[1]) + (s4[2] + s4[3])) * (1.0f / 256.0f) + EPS) * SCALE_A;
#pragma unroll
                    for (int bj = 0; bj < 2; ++bj) {
                        if (pn < 2) { const int g = 8 * pn + 4 * bj + wc; *(u32x4*)(QA + (size_t)row * 768 + (g >> 1) * 96 + 32 * (g & 1) + 8 * fq) = pack8(acc[ai][bj][m][0] * rs, acc[ai][bj][m][1] * rs); }
                        else { const int h = 4 * bj + wc; f32x4 o1, o2; rope4(TAB + (size_t)(row & (SEQ - 1)) * 16, fq, acc[ai][bj][m][0] * rs, acc[ai][bj][m][1] * rs, o1, o2);
                            bf16_t* p = QA + (size_t)row * 768 + h * 96 + 64 + 4 * fq; *(u32x2*)p = pack4(o1); *(u32x2*)(p + 16) = pack4(o2); } }
                } else {
                    const f32x4 s4 = *(const f32x4*)(SSKV + (size_t)row * 4); const float rs = rsqrt_(((s4[0] + s4[1]) + (s4[2] + s4[3])) * (1.0f / 128.0f) + EPS);
                    bf16_t* base = (pn < 5 ? KAN + (pn - 3) * 256 : VA + (pn - 5) * 256) + (size_t)row * 512 + wc * 32 + 8 * fq;
#pragma unroll
                    for (int bj = 0; bj < 2; ++bj) *(u32x4*)(base + bj * HALF) = pack8(acc[ai][bj][m][0] * rs, acc[ai][bj][m][1] * rs);
                } asm volatile("" ::: "memory"); }
    }
};

struct EpiMerge {
    static constexpr bool PERM = false, AFTER_DRAIN = false;
    const bf16_t* GATES; bf16_t* MG;
    __device__ __forceinline__ bool keep(const Unit& u) const { return u.sel == 0; }
    __device__ __forceinline__ void mid(f32x4 (&acc)[2][2][4][2], const Unit& u, int wr, int wc, int fr, int fq) const {
        const int row0 = u.pm * BM + wr * 64 + fr, col0 = u.pn * BM + wc * 32 + 8 * fq;
#pragma unroll
        for (int ai = 0; ai < 2; ++ai)
#pragma unroll
            for (int m = 0; m < 4; ++m) { const bf16_t* rowp = GATES + (size_t)(row0 + ai * HALF + m * 16) * 2048 + col0;
#pragma unroll
                for (int bj = 0; bj < 2; ++bj) { f32x4 a0, a1, b0, b1; unpack8(*(const u32x4*)(rowp + bj * HALF), a0, a1); unpack8(*(const u32x4*)(rowp + 1024 + bj * HALF), b0, b1);
#pragma unroll
                    for (int i = 0; i < 4; ++i) { acc[ai][bj][m][0][i] *= a0[i] * __builtin_amdgcn_rcpf(b0[i]); acc[ai][bj][m][1][i] *= a1[i] * __builtin_amdgcn_rcpf(b1[i]); } } }
    }
    __device__ __forceinline__ void operator()(AccRef acc, const Unit& u, int wr, int wc, int fr, int fq) const {
        const int row0 = u.pm * BM + wr * 64 + fr, col0 = u.pn * BM + wc * 32 + 8 * fq;
#pragma unroll
        for (int ai = 0; ai < 2; ++ai)
#pragma unroll
            for (int m = 0; m < 4; ++m) { const size_t r = (size_t)(row0 + ai * HALF + m * 16);
#pragma unroll
                for (int bj = 0; bj < 2; ++bj) { f32x4 b0, b1; unpack8(*(const u32x4*)(GATES + r * 2048 + 1024 + col0 + bj * HALF), b0, b1);
                    *(u32x4*)(MG + r * D + col0 + bj * HALF) = pack8(acc[ai][bj][m][0] * b0, acc[ai][bj][m][1] * b1); } }
    }
};

struct EpiRes {
    EPI_COMMON
    const float* base; float* out; bf16_t* XG; const float* gain; float* SS;
    __device__ __forceinline__ void operator()(AccRef acc, const Unit& u, int wr, int wc, int fr, int fq) const {
        const int row0 = u.pm * BM + wr * 64 + fr, col0 = u.pn * BM + wc * 32 + 8 * fq;
        f32x4 gv[2][2];
#pragma unroll
        for (int bj = 0; bj < 2; ++bj)
#pragma unroll
            for (int n = 0; n < 2; ++n) gv[bj][n] = *(const f32x4*)(gain + col0 + bj * HALF + 4 * n);
#pragma unroll
        for (int ai = 0; ai < 2; ++ai)
#pragma unroll
            for (int m = 0; m < 4; ++m) { const int row = row0 + ai * HALF + m * 16; const size_t off = (size_t)row * D + col0; float ss = 0.f;
#pragma unroll
                for (int bj = 0; bj < 2; ++bj) {
                    const f32x4 x0 = *(const f32x4*)(base + off + bj * HALF) + acc[ai][bj][m][0], x1 = *(const f32x4*)(base + off + bj * HALF + 4) + acc[ai][bj][m][1];
                    *(f32x4*)(out + off + bj * HALF) = x0; *(f32x4*)(out + off + bj * HALF + 4) = x1; ss += sumsq4(x0) + sumsq4(x1);
                    *(u32x4*)(XG + off + bj * HALF) = pack8(x0 * gv[bj][0], x1 * gv[bj][1]); }
                ss = red4x(ss); if (fq == 0) SS[(size_t)row * 16 + 4 * u.pn + wc] = ss; }
    }
};
__device__ __forceinline__ float row_rs16(const float* SS, int row) {
    const f32x4 a = *(const f32x4*)(SS + (size_t)row * 16), b = *(const f32x4*)(SS + (size_t)row * 16 + 4), c = *(const f32x4*)(SS + (size_t)row * 16 + 8), d = *(const f32x4*)(SS + (size_t)row * 16 + 12);
    const float s = (((a[0] + a[1]) + (a[2] + a[3])) + ((b[0] + b[1]) + (b[2] + b[3]))) + (((c[0] + c[1]) + (c[2] + c[3])) + ((d[0] + d[1]) + (d[2] + d[3])));
    return rsqrt_(s * (1.0f / 1024.0f) + EPS);
}
struct EpiUp {
    EPI_COMMON
    const float* SS; bf16_t* U;
    __device__ __forceinline__ void operator()(AccRef acc, const Unit& u, int wr, int wc, int fr, int fq) const {
        const int row0 = u.pm * BM + wr * 64 + fr, col0 = u.pn * BM + wc * 32 + 8 * fq;
#pragma unroll
        for (int ai = 0; ai < 2; ++ai)
#pragma unroll
            for (int m = 0; m < 4; ++m) { const int row = row0 + ai * HALF + m * 16; const float rs = row_rs16(SS, row); bf16_t* rowp = U + (size_t)row * FF + col0;
#pragma unroll
                for (int bj = 0; bj < 2; ++bj) { f32x4 v0 = acc[ai][bj][m][0] * rs, v1 = acc[ai][bj][m][1] * rs;
#pragma unroll
                    for (int i = 0; i < 4; ++i) { v0[i] = fmaxf(v0[i], 0.f); v1[i] = fmaxf(v1[i], 0.f); }
                    *(u32x4*)(rowp + bj * HALF) = pack8(v0 * v0, v1 * v1); } }
    }
};
struct EpiPG {
    EPI_COMMON
    const float* SSin; const bf16_t* PP; float* out; float* SSout;
    __device__ __forceinline__ void operator()(AccRef acc, const Unit& u, int wr, int wc, int fr, int fq) const {
        const int row0 = u.pm * BM + wr * 64 + fr, col0 = u.pn * BM + wc * 32 + 8 * fq;
#pragma unroll
        for (int ai = 0; ai < 2; ++ai)
#pragma unroll
            for (int m = 0; m < 4; ++m) { const int row = row0 + ai * HALF + m * 16; const float rs = row_rs16(SSin, row); const size_t off = (size_t)row * D + col0; float ss = 0.f;
#pragma unroll
                for (int bj = 0; bj < 2; ++bj) { f32x4 p0, p1; unpack8(*(const u32x4*)(PP + off + bj * HALF), p0, p1);
                    const f32x4 x0 = *(const f32x4*)(out + off + bj * HALF) + sigmoid4(acc[ai][bj][m][0] * rs) * p0, x1 = *(const f32x4*)(out + off + bj * HALF + 4) + sigmoid4(acc[ai][bj][m][1] * rs) * p1;
                    *(f32x4*)(out + off + bj * HALF) = x0; *(f32x4*)(out + off + bj * HALF + 4) = x1; ss += sumsq4(x0) + sumsq4(x1); }
                ss = red4x(ss); if (fq == 0) SSout[(size_t)row * 16 + 4 * u.pn + wc] = ss; }
    }
};
}

namespace att {
constexpr int KBUF = 12288, VBUF = 8192, LDS_K = 0, LDS_V = 2 * KBUF, LDS_WS = 2 * KBUF + 2 * VBUF, LDS_BYTES = LDS_WS + 8 * 256;
constexpr int NT = SEQ / 64;
__device__ __forceinline__ int crow(int r, int hi) { return (r & 3) + 8 * (r >> 2) + 4 * hi; }
__device__ __forceinline__ s16x4 vtr(const LAS unsigned char* p) { typedef short v4i16_t __attribute__((ext_vector_type(4))); return __builtin_bit_cast(s16x4, __builtin_amdgcn_ds_read_tr16_b64_v4i16((LAS v4i16_t*)p)); }

template <int DK>
__device__ __forceinline__ void attn_unit(LAS unsigned char* lds, const bf16_t* Qg, int qpitch, const bf16_t* Kg, int kpitch, const bf16_t* Kpe, const bf16_t* Vg, int vpitch, bf16_t* Og, int opitch) {
    constexpr int ND0 = DK / 16;
    int tid_ = threadIdx.x; asm volatile("" : "+v"(tid_));
    const int tid = tid_, lane = tid & 63, r32 = lane & 31, hi = lane >> 5, wid = __builtin_amdgcn_readfirstlane(tid >> 6);
    LAS float* wsf = (LAS float*)(lds + LDS_WS) + wid * 64;
    const bf16_t* ksrc0 = Kg + (size_t)lane * kpitch + wid * 8;
    const bf16_t* ksrc1 = (DK == 96) ? Kpe + (size_t)lane * 32 + (wid & 3) * 8 : nullptr;
    const bf16_t* vsrc = Vg + (size_t)(16 * (wid & 3) + (lane >> 2)) * vpitch + (wid >> 2) * 32 + (lane & 3) * 8;
#define ATT_ISSUE(t, buf) do { \
        __builtin_amdgcn_global_load_lds((const unsigned*)(ksrc0 + (size_t)(t) * 64 * kpitch), (LAS unsigned*)(lds + LDS_K + (buf) * KBUF + wid * 1024), 16, 0, 0); \
        if (DK == 96 && wid < 4) __builtin_amdgcn_global_load_lds((const unsigned*)(ksrc1 + (size_t)(t) * 64 * 32), (LAS unsigned*)(lds + LDS_K + (buf) * KBUF + (8 + wid) * 1024), 16, 0, 0); \
        __builtin_amdgcn_global_load_lds((const unsigned*)(vsrc + (size_t)(t) * 64 * vpitch), (LAS unsigned*)(lds + LDS_V + (buf) * VBUF + wid * 1024), 16, 0, 0); } while (0)
    ATT_ISSUE(0, 0);
    bf16x8 qr[ND0];
#pragma unroll
    for (int d0 = 0; d0 < ND0; ++d0) qr[d0] = *(const bf16x8*)(Qg + (size_t)(wid * 32 + r32) * qpitch + d0 * 16 + hi * 8);
    f32x16 o0 = {}, o1 = {}, negm = {};
    float mhat = 0.f, lsum = 0.f;
    const int vboff = ((lane >> 4) & 1) * 32 + (lane & 3) * 8 + (4 * hi + ((lane & 15) >> 2)) * 64;
    asm volatile("s_waitcnt vmcnt(0)" ::: "memory"); __syncthreads();
    for (int t = 0; t < NT; ++t) {
        const int buf = t & 1;
        if (t + 1 < NT) ATT_ISSUE(t + 1, buf ^ 1);
        const LAS unsigned char* kb = lds + LDS_K + buf * KBUF + hi * 1024 + r32 * 16;
        f32x16 p0 = negm, p1 = negm;
#pragma unroll
        for (int d0 = 0; d0 < ND0; ++d0) {
            const bf16x8 b0 = *(const LAS bf16x8*)(kb + d0 * 2048), b1 = *(const LAS bf16x8*)(kb + d0 * 2048 + 512);
            p0 = __builtin_amdgcn_mfma_f32_32x32x16_bf16(b0, qr[d0], p0, 0, 0, 0);
            p1 = __builtin_amdgcn_mfma_f32_32x32x16_bf16(b1, qr[d0], p1, 0, 0, 0);
        }
        float rm = fmaxf(p0[0], p1[0]);
#pragma unroll
        for (int r = 1; r < 16; ++r) rm = fmaxf(rm, fmaxf(p0[r], p1[r]));
        rm = fmaxf(rm, __shfl_xor(rm, 32));
        if (t == 0 || __any(rm > 8.0f)) {
            const float dl = (t == 0) ? rm : fmaxf(rm, 0.f);
            mhat += dl;
#pragma unroll
            for (int r = 0; r < 16; ++r) { p0[r] -= dl; p1[r] -= dl; negm[r] = -mhat; }
            if (t != 0) {
                const float f = __builtin_amdgcn_exp2f(-dl); lsum *= f;
                if (hi == 0) wsf[r32] = f;
                asm volatile("s_waitcnt lgkmcnt(0)" ::: "memory");
#pragma unroll
                for (int r = 0; r < 16; ++r) { const float fr_ = wsf[crow(r, hi)]; o0[r] *= fr_; o1[r] *= fr_; }
                asm volatile("s_waitcnt lgkmcnt(0)" ::: "memory");
            }
        }
        float sacc = 0.f;
#pragma unroll
        for (int r = 0; r < 16; ++r) { p0[r] = __builtin_amdgcn_exp2f(p0[r]); p1[r] = __builtin_amdgcn_exp2f(p1[r]); sacc += p0[r] + p1[r]; }
        lsum += sacc;
        u32x4 pw[4];
#pragma unroll
        for (int k = 0; k < 2; ++k)
#pragma unroll
            for (int j = 0; j < 4; ++j) { pw[k][j] = cvt_pk_bf16(p0[8 * k + 2 * j], p0[8 * k + 2 * j + 1]); pw[2 + k][j] = cvt_pk_bf16(p1[8 * k + 2 * j], p1[8 * k + 2 * j + 1]); }
        const LAS unsigned char* vb = lds + LDS_V + buf * VBUF + vboff;
#pragma unroll
        for (int ks = 0; ks < 4; ++ks) {
            const s16x4 l0 = vtr(vb + ks * 1024), h0 = vtr(vb + ks * 1024 + 512), l1 = vtr(vb + 4096 + ks * 1024), h1 = vtr(vb + 4096 + ks * 1024 + 512);
            const bf16x8 v0 = (bf16x8){l0[0], l0[1], l0[2], l0[3], h0[0], h0[1], h0[2], h0[3]}, v1 = (bf16x8){l1[0], l1[1], l1[2], l1[3], h1[0], h1[1], h1[2], h1[3]};
            const bf16x8 pa = __builtin_bit_cast(bf16x8, pw[ks]);
            o0 = __builtin_amdgcn_mfma_f32_32x32x16_bf16(pa, v0, o0, 0, 0, 0);
            o1 = __builtin_amdgcn_mfma_f32_32x32x16_bf16(pa, v1, o1, 0, 0, 0);
        }
        asm volatile("s_waitcnt vmcnt(0)" ::: "memory"); __syncthreads();
    }
#undef ATT_ISSUE
    lsum += __shfl_xor(lsum, 32);
    if (hi == 0) wsf[32 + r32] = lsum;
    asm volatile("s_waitcnt lgkmcnt(0)" ::: "memory");
#pragma unroll
    for (int r = 0; r < 16; ++r) { const int q = crow(r, hi); const float rl = __builtin_amdgcn_rcpf(wsf[32 + q]);
        bf16_t* op = Og + (size_t)(wid * 32 + q) * opitch + r32;
        op[0] = (bf16_t)(cvt_pk_bf16(o0[r] * rl, 0.f) & 0xffffu); op[32] = (bf16_t)(cvt_pk_bf16(o1[r] * rl, 0.f) & 0xffffu); }
    asm volatile("s_waitcnt lgkmcnt(0)" ::: "memory");
}
}

constexpr int NWAVES = 8;
constexpr int RING_BYTES = 131072, LDSCTL_OFF = RING_BYTES, MISC_OFF = LDSCTL_OFF + 320, LDS_BYTES = 147456;

__device__ __forceinline__ float wave_sum(float v) {
#pragma unroll
    for (int o = 1; o < 64; o <<= 1) v += __shfl_xor(v, o);
    return v;
}
__device__ __forceinline__ void map_group(int mat, int g, int& src, bool& perm) {
    perm = true;
    if (mat == 0) {
        if (g < 8) src = 32 * g;
        else if (g < 12) src = 256 + 32 * (g - 8);
        else if (g == 12) { src = 384; perm = false; }
        else if (g < 16) src = -1;
        else if (g < 32) { const int tt = (g - 16) >> 3, gi = (g - 16) & 7, bj = gi >> 2, wc = gi & 3; src = 416 + 64 * (4 * tt + wc) + 32 * bj; perm = false; }
        else if (g < 40) { const int gi = g - 32, bj = gi >> 2, wc = gi & 3; src = (wc < 2 ? 928 + 64 * wc : 1056 + 64 * (wc - 2)) + 32 * bj; perm = false; }
        else src = 1184 + 32 * (g - 40);
    } else if (mat == 1) {
        if (g < 16) src = 96 * (g >> 1) + 32 * (g & 1);
        else { src = 96 * (g - 16) + 64; perm = false; }
    } else if (mat == 2) {
        if (g < 16) src = 128 * (g >> 1) + 32 * (g & 1);
        else src = 128 * ((g - 16) >> 1) + 64 + 32 * ((g - 16) & 1);
    } else src = 32 * g;
}
__device__ __forceinline__ void tr_item(const float* W, int srcN, int srcK, int k0, int src, bool perm, const float* kscale, bf16_t* WT, int Kdst, int destrow0, LAS float* scr, int lane) {
    const bool zero = (src < 0) || (k0 >= srcK);
    if (!zero) {
#pragma unroll 8
        for (int i = 0; i < 32; ++i) { const int kk = 2 * i + (lane >> 5); float v = W[(size_t)(k0 + kk) * srcN + src + (lane & 31)]; if (kscale) v *= kscale[k0 + kk]; scr[kk * 33 + (lane & 31)] = v; }
    }
    asm volatile("s_waitcnt lgkmcnt(0)" ::: "memory");
    const int c = lane & 7;
#pragma unroll
    for (int j = 0; j < 4; ++j) { const int rho = (lane >> 3) + 8 * j, sidx = perm ? pg8::perm32(rho) : rho; const LAS float* s = scr + (8 * c) * 33 + sidx;
        u32x4 o = {0u, 0u, 0u, 0u};
        if (!zero) { o.x = cvt_pk_bf16(s[0 * 33], s[1 * 33]); o.y = cvt_pk_bf16(s[2 * 33], s[3 * 33]); o.z = cvt_pk_bf16(s[4 * 33], s[5 * 33]); o.w = cvt_pk_bf16(s[6 * 33], s[7 * 33]); }
        *(u32x4*)(WT + (size_t)(destrow0 + rho) * Kdst + k0 + 8 * c) = o; }
    asm volatile("s_waitcnt lgkmcnt(0)" ::: "memory");
}

#ifndef PHASE_MASK
#define PHASE_MASK 0x3ff
#endif
#ifndef USE_CG
#define USE_CG 0
#endif
struct Args { const float* in[20]; float* out; unsigned char* ws; double invf[16]; };

#ifndef DEBUG_STAGE
#define DEBUG_STAGE -1
#endif
__device__ __noinline__ void dbg_dump(float* out, int ocol, const bf16_t* src, int pitch, int n) {
    for (int row = blockIdx.x; row < T; row += gridDim.x)
        for (int c = threadIdx.x; c < n; c += NWAVES * 64) out[(size_t)row * D + ocol + c] = __uint_as_float((unsigned)src[(size_t)row * pitch + c] << 16);
}
__global__ void __launch_bounds__(NWAVES * 64, 2) fwd_megakernel(Args args) {
    extern __shared__ __attribute__((aligned(16))) unsigned char lds_raw[];
    LAS unsigned char* lds = (LAS unsigned char*)lds_raw;
    const int tid = threadIdx.x;
    const int G = gridDim.x, bx = blockIdx.x, vcu = (G % 8 == 0) ? (bx % 8) * (G / 8) + bx / 8 : bx;
    unsigned char* ws = args.ws;
    for (int u = tid; u < (LDS_BYTES - LDSCTL_OFF) / 4; u += NWAVES * 64) ((LAS unsigned*)(lds + LDSCTL_OFF))[u] = 0u;
    __syncthreads();
#if USE_CG
    cooperative_groups::grid_group cgrid = cooperative_groups::this_grid();
#define GRID_BAR() cgrid.sync()
#else
    XcdBarrier bar = xcd_barrier_post((unsigned*)(ws + WS_CTL) + CW_BAR, (volatile LAS unsigned*)(lds + MISC_OFF) + 8);
#define GRID_BAR() xcd_barrier(bar)
#endif

    const float* x = args.in[0]; const float* p = args.in[1];
    float* out = args.out;
    const f32x2* TAB = (const f32x2*)(ws + WS_TAB);
    const int NGW = G * NWAVES;

#if PHASE_MASK & (1 << 0)
    {
        int t0_ = threadIdx.x; asm volatile("" : "+v"(t0_)); const int tid = t0_, lane = t0_ & 63, wave = __builtin_amdgcn_readfirstlane(t0_ >> 6), gw = vcu * NWAVES + wave;
        LAS float* scr = (LAS float*)(lds + wave * 16384);
        constexpr int NMAT = 10;
        const int srcK[NMAT] = {1024, 256, 128, 512, 512, 1024, 1024, 4096, 1024, 256};
        (void)srcK;
        int it = gw;
#define MAT_ITEMS(KD, NG) (((KD) / 64) * (NG))
        constexpr int I0 = MAT_ITEMS(1024, 104), I1 = MAT_ITEMS(256, 24), I2 = MAT_ITEMS(256, 32), I3 = MAT_ITEMS(512, 32), I4 = I3, I5 = MAT_ITEMS(1024, 32), I6 = MAT_ITEMS(1024, 128),
                      I7 = MAT_ITEMS(4096, 32), I8 = I5, I9 = MAT_ITEMS(256, 32);
        constexpr int NITEMS = I0 + I1 + I2 + I3 + I4 + I5 + I6 + I7 + I8 + I9;
        for (; it < NITEMS; it += NGW) {
            int r = it, mat, sK, sN, Kd, ng; const float* W; const float* ks = nullptr; size_t wo;
            if (r < I0) { mat = 0; sK = 1024; sN = DIN; Kd = 1024; ng = 104; W = args.in[3]; wo = WS_WIN; }
            else if ((r -= I0) < I1) { mat = 1; sK = 256; sN = 768; Kd = 256; ng = 24; W = args.in[5]; ks = args.in[4]; wo = WS_WQB; }
            else if ((r -= I1) < I2) { mat = 2; sK = 128; sN = 1024; Kd = 256; ng = 32; W = args.in[7]; ks = args.in[6]; wo = WS_WKVB; }
            else if ((r -= I2) < I3) { mat = 3; sK = 512; sN = 1024; Kd = 512; ng = 32; W = args.in[10]; wo = WS_WOA; }
            else if ((r -= I3) < I4) { mat = 4; sK = 512; sN = 1024; Kd = 512; ng = 32; W = args.in[11]; wo = WS_WOB; }
            else if ((r -= I4) < I5) { mat = 5; sK = 1024; sN = 1024; Kd = 1024; ng = 32; W = args.in[12]; wo = WS_WO; }
            else if ((r -= I5) < I6) { mat = 6; sK = 1024; sN = 4096; Kd = 1024; ng = 128; W = args.in[14]; wo = WS_WUP; }
            else if ((r -= I6) < I7) { mat = 7; sK = 4096; sN = 1024; Kd = 4096; ng = 32; W = args.in[15]; wo = WS_WDN; }
            else if ((r -= I7) < I8) { mat = 8; sK = 1024; sN = 1024; Kd = 1024; ng = 32; W = args.in[17]; wo = WS_WPG; }
            else { r -= I8; mat = 9; sK = 256; sN = 1024; Kd = 256; ng = 32; W = args.in[18]; wo = WS_WPLE; }
            const int kb = r / ng, g = r % ng; int src; bool perm; map_group(mat, g, src, perm);
            tr_item(W, sN, sK, 64 * kb, src, perm, ks, (bf16_t*)(ws + wo), Kd, 32 * g, scr, lane);
        }
#undef MAT_ITEMS
        for (int e = bx * (NWAVES * 64) + tid; e < 2048 * 16; e += G * NWAVES * 64) {
            const int pos = e >> 4, j = e & 15;
            const double a = (double)pos * args.invf[j], rev = a * 0.15915494309189533577, fr = rev - __builtin_rint(rev), th = fr * 6.283185307179586477, t2 = th * th;
            double sc = 1.0, ss = 1.0;
#pragma unroll
            for (int k = 15; k >= 1; --k) { sc = 1.0 - sc * t2 / (double)((2 * k - 1) * (2 * k)); ss = 1.0 - ss * t2 / (double)((2 * k) * (2 * k + 1)); }
            ((f32x2*)(ws + WS_TAB))[e] = (f32x2){(float)sc, (float)(ss * th)};
        }
        { const float* gmix = args.in[2]; bf16_t* H0 = (bf16_t*)(ws + WS_XG);
          f32x4 gv[4];
#pragma unroll
          for (int j = 0; j < 4; ++j) gv[j] = ((const f32x4*)gmix)[lane + 64 * j];
          for (int m = gw; m < T; m += NGW) { const f32x4* xr = (const f32x4*)(x + (size_t)m * D) + lane; f32x4 v[4]; float s = 0.f;
#pragma unroll
              for (int j = 0; j < 4; ++j) { v[j] = xr[64 * j]; s += sumsq4(v[j]); }
              const float rs = rsqrt_(wave_sum(s) * (1.0f / D) + EPS);
              u32x2* o8 = (u32x2*)(H0 + (size_t)m * D) + lane;
#pragma unroll
              for (int j = 0; j < 4; ++j) o8[64 * j] = pack4(v[j] * rs * gv[j]); } }
        { bf16_t* PB = (bf16_t*)(ws + WS_PB);
          for (size_t c = (size_t)bx * (NWAVES * 64) + tid; c < (size_t)T * PLE / 8; c += (size_t)G * NWAVES * 64) {
              const f32x4 a = ((const f32x4*)p)[2 * c], b = ((const f32x4*)p)[2 * c + 1]; ((u32x4*)PB)[c] = pack8(a, b); } }
    }
#endif
    GRID_BAR();

#if PHASE_MASK & (1 << 1)
    {
        pg8::Gemm g{(const bf16_t*)(ws + WS_PB), nullptr, (const bf16_t*)(ws + WS_WPLE), nullptr, PLE};
        pg8::Order<0> S; S.init(T, D, G, bx);
        pg8::EpiPle E{(bf16_t*)(ws + WS_PP)};
        pg8::gemm_phase<pg8::EpiPle, pg8::Order<0>>(lds, g, S, E);
    }
#endif
#if PHASE_MASK & (1 << 1)
    {
        pg8::Gemm g{(const bf16_t*)(ws + WS_XG), nullptr, (const bf16_t*)(ws + WS_WIN), nullptr, D};
        pg8::Order<0> S; S.init(T, NIN, G, bx);
        pg8::EpiIn E{(bf16_t*)(ws + WS_QL), (bf16_t*)(ws + WS_KVL), (bf16_t*)(ws + WS_KPE), (bf16_t*)(ws + WS_QB), (bf16_t*)(ws + WS_KB), (bf16_t*)(ws + WS_VB), (bf16_t*)(ws + WS_GATES),
                     (float*)(ws + WS_SSQ), (float*)(ws + WS_SSKV), TAB, args.in[8], args.in[9]};
        pg8::gemm_phase<pg8::EpiIn, pg8::Order<0>>(lds, g, S, E);
    }
#endif
    GRID_BAR();

    if (DEBUG_STAGE == 1) { dbg_dump(out, 0, (const bf16_t*)(ws + WS_QB), 512, 512); dbg_dump(out, 512, (const bf16_t*)(ws + WS_KB), 128, 128); dbg_dump(out, 640, (const bf16_t*)(ws + WS_VB), 128, 128); dbg_dump(out, 768, (const bf16_t*)(ws + WS_KPE), 32, 32); dbg_dump(out, 800, (const bf16_t*)(ws + WS_QL), 256, 224); return; }
#if PHASE_MASK & (1 << 2)
    {
        pg8::Gemm g{(const bf16_t*)(ws + WS_QL), (const bf16_t*)(ws + WS_KVL), (const bf16_t*)(ws + WS_WQB), (const bf16_t*)(ws + WS_WKVB), 256};
        pg8::Order<1> S; S.init(T, 7 * 256, G, bx);
        pg8::EpiLat E{(bf16_t*)(ws + WS_QA), (bf16_t*)(ws + WS_KAN), (bf16_t*)(ws + WS_VA), (const float*)(ws + WS_SSQ), (const float*)(ws + WS_SSKV), TAB};
        pg8::gemm_phase<pg8::EpiLat, pg8::Order<1>>(lds, g, S, E);
    }
#endif
    GRID_BAR();

    if (DEBUG_STAGE == 2) { dbg_dump(out, 0, (const bf16_t*)(ws + WS_QA), 768, 768); dbg_dump(out, 768, (const bf16_t*)(ws + WS_KAN), 512, 128); dbg_dump(out, 896, (const bf16_t*)(ws + WS_VA), 512, 128); return; }
#if PHASE_MASK & (1 << 3)
    {
        const bf16_t* QA = (const bf16_t*)(ws + WS_QA); const bf16_t* KAN = (const bf16_t*)(ws + WS_KAN); const bf16_t* VA = (const bf16_t*)(ws + WS_VA); const bf16_t* KPE = (const bf16_t*)(ws + WS_KPE);
        const bf16_t* QB = (const bf16_t*)(ws + WS_QB); const bf16_t* KB = (const bf16_t*)(ws + WS_KB); const bf16_t* VB = (const bf16_t*)(ws + WS_VB);
        bf16_t* OA = (bf16_t*)(ws + WS_OA); bf16_t* OB = (bf16_t*)(ws + WS_OB);
        for (int w = vcu; w < BATCH * 8 * 8; w += G) {
            const int bh = w >> 3, qb = w & 7, b = bh >> 3, h = bh & 7; const size_t row0 = (size_t)b * SEQ + qb * 256, kr0 = (size_t)b * SEQ;
            att::attn_unit<96>(lds, QA + row0 * 768 + h * 96, 768, KAN + kr0 * 512 + h * 64, 512, KPE + kr0 * 32, VA + kr0 * 512 + h * 64, 512, OA + row0 * 512 + h * 64, 512);
        }
        for (int w = vcu; w < BATCH * 8 * 8; w += G) {
            const int grp = w >> 5, within = w & 31, b = grp >> 1, kvh = grp & 1, hq = kvh * 4 + (within >> 3), qb = within & 7; const size_t row0 = (size_t)b * SEQ + qb * 256, kr0 = (size_t)b * SEQ;
            att::attn_unit<64>(lds, QB + row0 * 512 + hq * 64, 512, KB + kr0 * 128 + kvh * 64, 128, nullptr, VB + kr0 * 128 + kvh * 64, 128, OB + row0 * 512 + hq * 64, 512);
        }
    }
#endif
    GRID_BAR();

    if (DEBUG_STAGE == 3) { dbg_dump(out, 0, (const bf16_t*)(ws + WS_OA), 512, 512); dbg_dump(out, 512, (const bf16_t*)(ws + WS_OB), 512, 512); return; }
#if PHASE_MASK & (1 << 4)
    {
        pg8::Gemm g{(const bf16_t*)(ws + WS_OA), (const bf16_t*)(ws + WS_OB), (const bf16_t*)(ws + WS_WOA), (const bf16_t*)(ws + WS_WOB), 512};
        pg8::Order<2> S; S.init(T, D, G, bx);
        pg8::EpiMerge E{(const bf16_t*)(ws + WS_GATES), (bf16_t*)(ws + WS_MG)};
        pg8::gemm_phase<pg8::EpiMerge, pg8::Order<2>>(lds, g, S, E);
    }
#endif
    GRID_BAR();

    if (DEBUG_STAGE == 4) { dbg_dump(out, 0, (const bf16_t*)(ws + WS_MG), 1024, 1024); return; }
#if PHASE_MASK & (1 << 5)
    {
        pg8::Gemm g{(const bf16_t*)(ws + WS_MG), nullptr, (const bf16_t*)(ws + WS_WO), nullptr, D};
        pg8::Order<0> S; S.init(T, D, G, bx);
        pg8::EpiRes E{x, out, (bf16_t*)(ws + WS_XG), args.in[13], (float*)(ws + WS_SS1)};
        pg8::gemm_phase<pg8::EpiRes, pg8::Order<0>>(lds, g, S, E);
    }
#endif
    GRID_BAR();

    if (DEBUG_STAGE == 5) return;
#if PHASE_MASK & (1 << 6)
    {
        pg8::Gemm g{(const bf16_t*)(ws + WS_XG), nullptr, (const bf16_t*)(ws + WS_WUP), nullptr, D};
        pg8::Order<0> S; S.init(T, FF, G, bx);
        pg8::EpiUp E{(const float*)(ws + WS_SS1), (bf16_t*)(ws + WS_U)};
        pg8::gemm_phase<pg8::EpiUp, pg8::Order<0>>(lds, g, S, E);
    }
#endif
    GRID_BAR();

#if PHASE_MASK & (1 << 7)
    {
        pg8::Gemm g{(const bf16_t*)(ws + WS_U), nullptr, (const bf16_t*)(ws + WS_WDN), nullptr, FF};
        pg8::Order<0> S; S.init(T, D, G, bx);
        pg8::EpiRes E{out, out, (bf16_t*)(ws + WS_XG), args.in[16], (float*)(ws + WS_SS2)};
        pg8::gemm_phase<pg8::EpiRes, pg8::Order<0>>(lds, g, S, E);
    }
#endif
    GRID_BAR();

    if (DEBUG_STAGE == 7) return;
#if PHASE_MASK & (1 << 8)
    {
        pg8::Gemm g{(const bf16_t*)(ws + WS_XG), nullptr, (const bf16_t*)(ws + WS_WPG), nullptr, D};
        pg8::Order<0> S; S.init(T, D, G, bx);
        pg8::EpiPG E{(const float*)(ws + WS_SS2), (const bf16_t*)(ws + WS_PP), out, (float*)(ws + WS_SS3)};
        pg8::gemm_phase<pg8::EpiPG, pg8::Order<0>>(lds, g, S, E);
    }
#endif
    GRID_BAR();

#if PHASE_MASK & (1 << 9)
    {
        int t9 = threadIdx.x; asm volatile("" : "+v"(t9)); const int lane = t9 & 63, gw = vcu * NWAVES + __builtin_amdgcn_readfirstlane(t9 >> 6);
        const float* gf = args.in[19]; const float* SS3 = (const float*)(ws + WS_SS3);
        f32x4 gv[4];
#pragma unroll
        for (int j = 0; j < 4; ++j) gv[j] = ((const f32x4*)gf)[lane + 64 * j];
        for (int m = gw; m < T; m += NGW) { const float rs = pg8::row_rs16(SS3, m); f32x4* xr = (f32x4*)(out + (size_t)m * D) + lane;
#pragma unroll
            for (int j = 0; j < 4; ++j) xr[64 * j] = xr[64 * j] * rs * gv[j]; }
    }
#endif
}

extern "C" void kernel_launch(void* const* d_in, const int* in_sizes, int n_in, void* d_out, int out_size, void* d_ws, size_t ws_size, hipStream_t stream) {
    static int grid = 0;
    if (grid == 0) {
        if (n_in != 20 || in_sizes[0] != T * D || out_size != T * D || ws_size < WS_END) { fprintf(stderr, "kernel_launch: unexpected problem shape (n_in %d, in0 %d, out %d, ws %zu); nothing launched\n", n_in, n_in > 0 ? in_sizes[0] : -1, out_size, ws_size); grid = -1; return; }
        int dev = 0, cus = 0;
        if (hipGetDevice(&dev) != hipSuccess || hipDeviceGetAttribute(&cus, hipDeviceAttributeMultiprocessorCount, dev) != hipSuccess) { grid = -1; return; }
        if (hipFuncSetAttribute((const void*)fwd_megakernel, hipFuncAttributeMaxDynamicSharedMemorySize, LDS_BYTES) != hipSuccess) { fprintf(stderr, "kernel_launch: hipFuncSetAttribute failed\n"); grid = -1; return; }
        grid = cus;
    }
    if (grid < 0) return;
    (void)hipMemsetAsync((char*)d_ws + WS_CTL, 0, CTL_ZERO_BYTES, stream);
    Args a{};
    for (int i = 0; i < 20; ++i) a.in[i] = (const float*)d_in[i];
    a.out = (float*)d_out; a.ws = (unsigned char*)d_ws;
    for (int j = 0; j < 16; ++j) a.invf[j] = std::pow(10000.0, -(double)j / 16.0);
#if USE_CG
    void* kargs[] = {&a};
    (void)hipLaunchCooperativeKernel((const void*)fwd_megakernel, dim3(grid), dim3(NWAVES * 64), kargs, LDS_BYTES, stream);
#else
    hipLaunchKernelGGL(fwd_megakernel, dim3(grid), dim3(NWAVES * 64), LDS_BYTES, stream, a);
#endif
}
```

```cpp
#include <hip/hip_runtime.h>
#include <hip/hip_cooperative_groups.h>
#include <cstdio>
#include <cstdint>
#include <cmath>

#define GAS __attribute__((address_space(1)))
#define LAS __attribute__((address_space(3)))
typedef unsigned short bf16_t;
typedef short bf16x8 __attribute__((ext_vector_type(8)));
typedef short s16x4 __attribute__((ext_vector_type(4)));
typedef float f32x2 __attribute__((ext_vector_type(2)));
typedef float f32x4 __attribute__((ext_vector_type(4)));
typedef float f32x16 __attribute__((ext_vector_type(16)));
typedef unsigned u32x2 __attribute__((ext_vector_type(2)));
typedef unsigned u32x4 __attribute__((ext_vector_type(4)));

constexpr int BATCH = 16, SEQ = 2048, T = BATCH * SEQ, D = 1024, FF = 4096, PLE = 256;
constexpr int DIN = 3232, NIN = 3328;
constexpr float EPS = 1e-6f;
constexpr float LOG2E = 1.4426950408889634f;
constexpr float SCALE_A = 0.10206207261596577f * LOG2E;
constexpr float SCALE_B = 0.125f * LOG2E;

constexpr size_t MiB = 1u << 20;
constexpr size_t WS_CTL = 0, CTL_ZERO_BYTES = 1 * MiB;
constexpr size_t WS_TAB = 1 * MiB;
constexpr size_t WS_SSQ = WS_TAB + 512 * 1024;
constexpr size_t WS_SSKV = 2 * MiB;
constexpr size_t WS_SS1 = 3 * MiB, WS_SS2 = 5 * MiB, WS_SS3 = 7 * MiB;
constexpr size_t WS_WIN = 10 * MiB, WS_WQB = 17 * MiB, WS_WKVB = 17 * MiB + 512 * 1024, WS_WOA = 18 * MiB, WS_WOB = 19 * MiB, WS_WO = 20 * MiB,
                 WS_WUP = 22 * MiB, WS_WDN = 30 * MiB, WS_WPG = 38 * MiB, WS_WPLE = 40 * MiB;
constexpr size_t WS_PP = 48 * MiB;
constexpr size_t WS_XG = 112 * MiB;
constexpr size_t WS_OA = 112 * MiB, WS_OB = 144 * MiB;
constexpr size_t WS_X3 = 176 * MiB;
constexpr size_t WS_U = 176 * MiB;
constexpr size_t WS_GATES = 176 * MiB;
constexpr size_t WS_QA = 304 * MiB;
constexpr size_t WS_PB = 304 * MiB;
constexpr size_t WS_MG = 304 * MiB;
constexpr size_t WS_KAN = 352 * MiB, WS_VA = 384 * MiB;
constexpr size_t WS_QB = 416 * MiB;
constexpr size_t WS_KB = 448 * MiB, WS_VB = 456 * MiB;
constexpr size_t WS_KPE = 464 * MiB;
constexpr size_t WS_QL = 466 * MiB, WS_KVL = 482 * MiB;
constexpr size_t WS_END = 498 * MiB;

constexpr int CW_BAR = 4096;

typedef __bf16 bf16x2_t __attribute__((ext_vector_type(2)));
__device__ __forceinline__ unsigned cvt_pk_bf16(float lo, float hi) { f32x2 v = {lo, hi}; bf16x2_t b = __builtin_convertvector(v, bf16x2_t); return __builtin_bit_cast(unsigned, b); }
__device__ __forceinline__ u32x4 pack8(f32x4 a, f32x4 b) { u32x4 w; w.x = cvt_pk_bf16(a[0], a[1]); w.y = cvt_pk_bf16(a[2], a[3]); w.z = cvt_pk_bf16(b[0], b[1]); w.w = cvt_pk_bf16(b[2], b[3]); return w; }
__device__ __forceinline__ u32x2 pack4(f32x4 a) { u32x2 w; w.x = cvt_pk_bf16(a[0], a[1]); w.y = cvt_pk_bf16(a[2], a[3]); return w; }
__device__ __forceinline__ void unpack8(u32x4 w, f32x4& a, f32x4& b) {
    a[0] = __uint_as_float(w.x << 16); a[1] = __uint_as_float(w.x & 0xffff0000u); a[2] = __uint_as_float(w.y << 16); a[3] = __uint_as_float(w.y & 0xffff0000u);
    b[0] = __uint_as_float(w.z << 16); b[1] = __uint_as_float(w.z & 0xffff0000u); b[2] = __uint_as_float(w.w << 16); b[3] = __uint_as_float(w.w & 0xffff0000u); }
__device__ __forceinline__ float sigmoidf_(float x) { return __builtin_amdgcn_rcpf(1.0f + __builtin_amdgcn_exp2f(-LOG2E * x)); }
__device__ __forceinline__ f32x4 sigmoid4(f32x4 v) { f32x4 o; o[0] = sigmoidf_(v[0]); o[1] = sigmoidf_(v[1]); o[2] = sigmoidf_(v[2]); o[3] = sigmoidf_(v[3]); return o; }
__device__ __forceinline__ float sumsq4(f32x4 v) { return (v[0] * v[0] + v[1] * v[1]) + (v[2] * v[2] + v[3] * v[3]); }
__device__ __forceinline__ float rsqrt_(float v) { return 1.0f / sqrtf(v); }
__device__ __forceinline__ float red4x(float s) { s += __shfl_xor(s, 16); s += __shfl_xor(s, 32); return s; }
#define XB_TMO      128
#define XB_XCNT(j)  (256  + 64 * (j))
#define XB_XSUB(j)  (1280 + 64 * (j))
#define XB_XGEN(j)  (2304 + 64 * (j))
#define XB_TOP      3328
#define XB_TOPGEN   3392
#define XCD_BAR_WORDS 3456
#define XB_SPIN_CAP (1u << 18)

__device__ __forceinline__ unsigned xb_ld(unsigned* p)              { return __hip_atomic_load(p, __ATOMIC_RELAXED, __HIP_MEMORY_SCOPE_AGENT); }
__device__ __forceinline__ unsigned xb_add(unsigned* p, unsigned v) { return __hip_atomic_fetch_add(p, v, __ATOMIC_RELAXED, __HIP_MEMORY_SCOPE_AGENT); }
__device__ __forceinline__ unsigned xb_xcc_id() { return (unsigned)__builtin_amdgcn_s_getreg((3 << 11) | 20) & 0xFu; }
#define XB_SPIN(cond, bar) do { unsigned _sp = 0; while (cond) { __builtin_amdgcn_s_sleep(1); \
    if ((++_sp & 255u) == 0u) { if (xb_ld(&(bar)[XB_TMO])) break; if (_sp > XB_SPIN_CAP) { atomicAdd(&(bar)[XB_TMO], 1u); break; } } } } while (0)

struct XcdBarrier { unsigned* bar; unsigned x; volatile LAS unsigned* st; };

__device__ __forceinline__ XcdBarrier xcd_barrier_post(unsigned* bar, volatile LAS unsigned* st) {
    XcdBarrier b; b.bar = bar; b.x = xb_xcc_id(); b.st = st;
    if (threadIdx.x == 0) (void)xb_add(&bar[XB_XCNT(b.x)], 1u);
    return b;
}
__device__ __forceinline__ void xcd_barrier_complete(unsigned* bar, unsigned x, unsigned& nloc, unsigned& nx) {
    const unsigned G = gridDim.x * gridDim.y * gridDim.z;
    unsigned sum, cnt, mine, sp = 0u;
    for (;;) {
        sum = 0u; cnt = 0u; mine = 0u;
#pragma unroll
        for (unsigned j = 0; j < 16; ++j) { const unsigned c = xb_ld(&bar[XB_XCNT(j)]); sum += c; cnt += (c > 0u) ? 1u : 0u; mine = (j == x) ? c : mine; }
        if (sum == G) break;
        __builtin_amdgcn_s_sleep(1);
        if ((++sp & 255u) == 0u) { if (xb_ld(&bar[XB_TMO])) break; if (sp > XB_SPIN_CAP) { atomicAdd(&bar[XB_TMO], 1u); break; } }
    }
    nloc = mine > 0u ? mine : 1u; nx = cnt > 0u ? cnt : 1u;
}
__device__ __forceinline__ void xcd_barrier(const XcdBarrier& b) {
    asm volatile("s_waitcnt vmcnt(0)" ::: "memory");
    __syncthreads();
    if (threadIdx.x == 0) {
        unsigned* bar = b.bar;
        __builtin_amdgcn_s_waitcnt(0);
        unsigned nloc = b.st[0], nx = b.st[1];
        if (nloc == 0u) { xcd_barrier_complete(bar, b.x, nloc, nx); b.st[0] = nloc; b.st[1] = nx; }
        const unsigned old = xb_add(&bar[XB_XSUB(b.x)], 1u);
        const unsigned gen = old / nloc;
        if (old + 1u == (gen + 1u) * nloc) {
            __builtin_amdgcn_fence(__ATOMIC_RELEASE, "agent");
            asm volatile("s_waitcnt vmcnt(0)" ::: "memory");
            const unsigned og = xb_add(&bar[XB_TOP], 1u);
            const unsigned tg = og / nx;
            if (og + 1u == (tg + 1u) * nx) xb_add(&bar[XB_TOPGEN], 1u);
            else XB_SPIN(xb_ld(&bar[XB_TOPGEN]) == tg, bar);
            __builtin_amdgcn_fence(__ATOMIC_ACQUIRE, "agent");
            xb_add(&bar[XB_XGEN(b.x)], 1u);
            asm volatile("s_waitcnt vmcnt(0)" ::: "memory");
        } else {
            XB_SPIN(xb_ld(&bar[XB_XGEN(b.x)]) == gen, bar);
            __builtin_amdgcn_fence(__ATOMIC_ACQUIRE, "agent");
            asm volatile("s_waitcnt vmcnt(0)" ::: "memory");
        }
    }
    __syncthreads();
}


namespace pg8 {
#define PG8_LAS __attribute__((address_space(3)))
constexpr int BM = 256, BK = 64, HALF = 128, HTB = HALF * BK * 2  , STAGE_BYTES = 8 * HTB, NXCD = 8, WGM = 8;

__host__ __device__ __forceinline__ int lds_byte(int r, int c) { const int st = (r >> 4) * 2 + (c >> 5), rr = r & 15, cc = c & 31, ob = rr * 64 + cc * 2; return st * 1024 + (ob ^ (((ob >> 9) & 1) << 5)); }
__host__ __device__ __forceinline__ void stage_rc(int b, int& R, int& C) { const int st = b / 1024, sb = b % 1024, swz = sb ^ (((sb >> 9) & 1) << 5); R = (st >> 1) * 16 + swz / 64; C = (st & 1) * 32 + (swz % 64) / 2; }
__host__ __device__ __forceinline__ int perm32(int rho) { const int n = rho >> 4, i = rho & 15; return 8 * (i >> 2) + 4 * n + (i & 3); }


struct Unit { int pm, pn, sel, pnb; };
struct Gemm { const bf16_t* A0; const bf16_t* A1; const bf16_t* B0; const bf16_t* B1; int K; };

template <int MODE> struct Order {
    int nM, nN, nwg, G, c;
    __device__ void init(int M, int N, int G_, int c_) { nM = M / BM; nN = N / BM; nwg = nM * nN; G = G_; c = c_; }
    __device__ bool next(int i, Unit& u) const {
        const int ii = (MODE == 2) ? (i >> 1) : i;
        if (MODE == 3 && c < G / 2) return false;
        const long L = (MODE == 3) ? (long)ii * (G / 2) + (c - G / 2) : (long)ii * G + c; if (L >= nwg) return false;
        int wgid = (int)L; { const int q = nwg / NXCD, r = nwg % NXCD, xcd = wgid % NXCD, off = wgid / NXCD; wgid = (xcd < r ? xcd * (q + 1) : r * (q + 1) + (xcd - r) * q) + off; }
        const int nig = WGM * nN, gid = wgid / nig, fm = gid * WGM, gsz = (nM - fm) < WGM ? (nM - fm) : WGM;
        u.pm = fm + ((wgid % nig) % gsz); u.pn = (wgid % nig) / gsz;
        if (MODE == 0 || MODE == 3) { u.sel = 0; u.pnb = u.pn; }
        else if (MODE == 1) { u.sel = (u.pn >= 3) ? 1 : 0; u.pnb = u.sel ? u.pn - 3 : u.pn; }
        else { u.sel = i & 1; u.pnb = u.pn; }
        return true;
    }
};
template <class Epi, class Sched, bool ALIGN_EPI = true, bool SP2 = true>
__device__ __forceinline__ void gemm_phase(PG8_LAS unsigned char* lds, const Gemm g, const Sched& S, const Epi& E) {
    int tid_ = threadIdx.x; asm volatile("" : "+v"(tid_));
    const int tid = tid_, wid = __builtin_amdgcn_readfirstlane(tid >> 6), lane = tid & 63, wr = wid >> 2, wc = wid & 3, fr = lane & 15, fq = lane >> 4;
    const int K = g.K, nt = K / BK;
    unsigned voffA[2], voffB[2];
#pragma unroll
    for (int i = 0; i < 2; ++i) { int R, C; stage_rc(tid * 16 + i * 8192, R, C); const int Rb = Epi::PERM ? ((R & ~31) + perm32(R & 31)) : R;
        voffA[i] = (unsigned)(R * K + C) * 2u; voffB[i] = (unsigned)(Rb * K + C) * 2u; }
    const size_t kstep = (size_t)(BK * 2);
    const size_t hstep = (size_t)HALF * K * 2;
    const size_t tstep = 2 * hstep;
    const unsigned ldsw = (unsigned)wid * 1024u;
    const int aoff = lds_byte(wr * 64 + fr, fq * 8), boff = lds_byte(wc * 32 + fr, fq * 8);
#define PG8_SA(b, h) (((b) * 2 + (h)) * HTB)
#define PG8_SB(b, h) ((4 + (b) * 2 + (h)) * HTB)
#define PG8_STAGE(bufoff, gbase, voff) do { _Pragma("unroll") for (int _i = 0; _i < 2; ++_i) \
        __builtin_amdgcn_global_load_lds((const unsigned*)((const char*)(gbase) + (voff)[_i]), (PG8_LAS unsigned*)(lds + (bufoff) + ldsw + _i * 8192), 16, 0, 0); } while (0)
#define PG8_LDA(dst, b, h) do { _Pragma("unroll") for (int m = 0; m < 4; ++m) _Pragma("unroll") for (int k = 0; k < 2; ++k) dst[m][k] = *(const PG8_LAS bf16x8*)(lds + PG8_SA(b, h) + aoff + m * 2048 + k * 1024); } while (0)
#define PG8_LDB(dst, b, h) do { _Pragma("unroll") for (int n = 0; n < 2; ++n) _Pragma("unroll") for (int k = 0; k < 2; ++k) dst[n][k] = *(const PG8_LAS bf16x8*)(lds + PG8_SB(b, h) + boff + n * 2048 + k * 1024); } while (0)
#define PG8_MMA(ai, bj, At, Bt) do { __builtin_amdgcn_s_setprio(1); _Pragma("unroll") for (int m = 0; m < 4; ++m) _Pragma("unroll") for (int n = 0; n < 2; ++n) _Pragma("unroll") for (int k = 0; k < 2; ++k) \
        acc[ai][bj][m][n] = __builtin_amdgcn_mfma_f32_16x16x32_bf16(Bt[n][k], At[m][k], acc[ai][bj][m][n], 0, 0, 0); __builtin_amdgcn_s_setprio(0); } while (0)
#define PG8_WAIT_V(n) asm volatile("s_waitcnt vmcnt(" #n ")" ::: "memory")
#define PG8_WAIT_L(n) asm volatile("s_waitcnt lgkmcnt(" #n ")" ::: "memory")
#define PG8_BAR __builtin_amdgcn_s_barrier()
#define PG8_SCHED __builtin_amdgcn_sched_barrier(0)
    Unit cur, nxt; int ui = 0;
    if (!S.next(0, cur)) return;
    f32x4 acc[2][2][4][2];
#pragma unroll
    for (int a = 0; a < 2; ++a)
#pragma unroll
        for (int b = 0; b < 2; ++b)
#pragma unroll
            for (int m = 0; m < 4; ++m)
#pragma unroll
                for (int n = 0; n < 2; ++n) acc[a][b][m][n] = (f32x4){0.f, 0.f, 0.f, 0.f};
    bf16x8 At[4][2], B0[2][2], B1[2][2];
    const char* cA = (const char*)(cur.sel ? g.A1 : g.A0) + (size_t)cur.pm * tstep; const char* cB = (const char*)(cur.sel ? g.B1 : g.B0) + (size_t)cur.pnb * tstep;
    if constexpr (SP2) {
        PG8_STAGE(PG8_SB(0, 0), cB, voffB); PG8_STAGE(PG8_SB(0, 1), cB + hstep, voffB); PG8_STAGE(PG8_SA(0, 0), cA, voffA); PG8_STAGE(PG8_SA(0, 1), cA + hstep, voffA);
        if (wr == 1) PG8_BAR;
        PG8_WAIT_V(2); PG8_BAR;
        PG8_STAGE(PG8_SB(1, 0), cB + kstep, voffB); PG8_STAGE(PG8_SA(1, 0), cA + kstep, voffA); PG8_STAGE(PG8_SB(1, 1), cB + hstep + kstep, voffB);
        PG8_WAIT_V(6); PG8_BAR;
    } else {
        PG8_STAGE(PG8_SB(0, 0), cB, voffB); PG8_STAGE(PG8_SA(0, 0), cA, voffA); PG8_STAGE(PG8_SB(0, 1), cB + hstep, voffB); PG8_STAGE(PG8_SA(0, 1), cA + hstep, voffA);
        if (wr == 1) PG8_BAR;
        PG8_WAIT_V(4); PG8_BAR;
        PG8_STAGE(PG8_SB(1, 0), cB + kstep, voffB); PG8_STAGE(PG8_SA(1, 0), cA + kstep, voffA); PG8_STAGE(PG8_SB(1, 1), cB + hstep + kstep, voffB);
        PG8_WAIT_V(6); PG8_BAR;
    }
    for (;;) {
        const bool has_next = S.next(ui + 1, nxt);
        const char* nA = has_next ? (const char*)(nxt.sel ? g.A1 : g.A0) + (size_t)nxt.pm * tstep : cA; const char* nB = has_next ? (const char*)(nxt.sel ? g.B1 : g.B0) + (size_t)nxt.pnb * tstep : cB;
        for (int t = 0; t < nt; t += 2) {
            const bool last = (t == nt - 2);
            const char* a1 = cA + (size_t)(t + 1) * kstep;
            const char* a2 = last ? nA : cA + (size_t)(t + 2) * kstep; const char* b2 = last ? nB : cB + (size_t)(t + 2) * kstep;
            const char* a3 = a2 + kstep; const char* b3 = b2 + kstep;
            if constexpr (SP2) {
            PG8_LDB(B0, 0, 0); PG8_LDB(B1, 0, 1); PG8_SCHED; PG8_LDA(At, 0, 0); PG8_STAGE(PG8_SA(1, 1), a1 + hstep, voffA);
            PG8_WAIT_V(8); PG8_WAIT_L(0); PG8_BAR; PG8_MMA(0, 0, At, B0); PG8_MMA(0, 1, At, B1); PG8_BAR; PG8_SCHED;
            PG8_LDA(At, 0, 1); PG8_STAGE(PG8_SB(0, 0), b2, voffB); PG8_STAGE(PG8_SB(0, 1), b2 + hstep, voffB); PG8_STAGE(PG8_SA(0, 0), a2, voffA);
            PG8_WAIT_V(8); PG8_WAIT_L(0); PG8_BAR; PG8_MMA(1, 0, At, B0); PG8_MMA(1, 1, At, B1); PG8_BAR; PG8_SCHED;
            PG8_LDB(B0, 1, 0); PG8_LDB(B1, 1, 1); PG8_SCHED; PG8_LDA(At, 1, 0); PG8_STAGE(PG8_SA(0, 1), a2 + hstep, voffA);
            PG8_WAIT_V(8); PG8_WAIT_L(0); PG8_BAR; PG8_MMA(0, 0, At, B0); PG8_MMA(0, 1, At, B1); PG8_BAR; PG8_SCHED;
            PG8_LDA(At, 1, 1); PG8_STAGE(PG8_SB(1, 0), b3, voffB); PG8_STAGE(PG8_SB(1, 1), b3 + hstep, voffB); PG8_STAGE(PG8_SA(1, 0), a3, voffA);
            PG8_WAIT_V(8); PG8_WAIT_L(0); PG8_BAR; PG8_MMA(1, 0, At, B0); PG8_MMA(1, 1, At, B1); PG8_BAR; PG8_SCHED;
            } else {
            PG8_LDB(B0, 0, 0); PG8_SCHED; PG8_LDA(At, 0, 0); PG8_STAGE(PG8_SA(1, 1), a1 + hstep, voffA);
            PG8_WAIT_L(8); PG8_BAR; PG8_WAIT_L(0); PG8_MMA(0, 0, At, B0); PG8_BAR; PG8_SCHED;
            PG8_LDB(B1, 0, 1); PG8_STAGE(PG8_SB(0, 0), b2, voffB);
            PG8_BAR; PG8_WAIT_L(0); PG8_MMA(0, 1, At, B1); PG8_BAR;
            PG8_LDA(At, 0, 1); PG8_STAGE(PG8_SA(0, 0), a2, voffA);
            PG8_BAR; PG8_WAIT_L(0); PG8_MMA(1, 0, At, B0); PG8_BAR; PG8_SCHED;
            PG8_STAGE(PG8_SB(0, 1), b2 + hstep, voffB);
            PG8_WAIT_V(6); PG8_BAR; PG8_MMA(1, 1, At, B1); PG8_BAR;
            PG8_LDB(B0, 1, 0); PG8_SCHED; PG8_LDA(At, 1, 0); PG8_STAGE(PG8_SA(0, 1), a2 + hstep, voffA);
            PG8_WAIT_L(8); PG8_BAR; PG8_WAIT_L(0); PG8_MMA(0, 0, At, B0); PG8_BAR; PG8_SCHED;
            PG8_LDB(B1, 1, 1); PG8_STAGE(PG8_SB(1, 0), b3, voffB);
            PG8_BAR; PG8_WAIT_L(0); PG8_MMA(0, 1, At, B1); PG8_BAR;
            PG8_LDA(At, 1, 1); PG8_STAGE(PG8_SA(1, 0), a3, voffA);
            PG8_BAR; PG8_WAIT_L(0); PG8_MMA(1, 0, At, B0); PG8_BAR; PG8_SCHED;
            PG8_STAGE(PG8_SB(1, 1), b3 + hstep, voffB);
            PG8_WAIT_V(6); PG8_BAR; PG8_MMA(1, 1, At, B1); PG8_BAR;
            }
        }
        if constexpr (ALIGN_EPI) { if (wr == 0) PG8_BAR; }
        const bool keep = E.keep(cur);
        if (keep) E.mid(acc, cur, wr, wc, fr, fq); else E(acc, cur, wr, wc, fr, fq);
        if (!has_next) break;
        if (!keep)
#pragma unroll
        for (int a = 0; a < 2; ++a)
#pragma unroll
            for (int b = 0; b < 2; ++b)
#pragma unroll
                for (int m = 0; m < 4; ++m)
#pragma unroll
                    for (int n = 0; n < 2; ++n) acc[a][b][m][n] = (f32x4){0.f, 0.f, 0.f, 0.f};
        cur = nxt; cA = nA; cB = nB; ++ui;
        if constexpr (ALIGN_EPI) { if (wr == 1) PG8_BAR; }
    }
    PG8_WAIT_V(0);
    if constexpr (!ALIGN_EPI) { if (wr == 0) PG8_BAR; }
    PG8_BAR;
#undef PG8_SA
#undef PG8_SB
#undef PG8_STAGE
#undef PG8_LDA
#undef PG8_LDB
#undef PG8_MMA
#undef PG8_WAIT_V
#undef PG8_WAIT_L
#undef PG8_BAR
#undef PG8_SCHED
}

#define EPI_COMMON static constexpr bool PERM = false, AFTER_DRAIN = false; \
    __device__ __forceinline__ bool keep(const Unit&) const { return false; } \
    __device__ __forceinline__ void mid(f32x4 (&)[2][2][4][2], const Unit&, int, int, int, int) const {}
typedef const f32x4 (&AccRef)[2][2][4][2];

__device__ __forceinline__ void rope4(const f32x2* tabrow, int fq, f32x4 x1, f32x4 x2, f32x4& o1, f32x4& o2) {
    const f32x4 t0 = *(const f32x4*)(tabrow + 4 * fq), t1 = *(const f32x4*)(tabrow + 4 * fq + 2);
    o1[0] = x1[0] * t0[0] - x2[0] * t0[1]; o2[0] = x1[0] * t0[1] + x2[0] * t0[0];
    o1[1] = x1[1] * t0[2] - x2[1] * t0[3]; o2[1] = x1[1] * t0[3] + x2[1] * t0[2];
    o1[2] = x1[2] * t1[0] - x2[2] * t1[1]; o2[2] = x1[2] * t1[1] + x2[2] * t1[0];
    o1[3] = x1[3] * t1[2] - x2[3] * t1[3]; o2[3] = x1[3] * t1[3] + x2[3] * t1[2];
}

struct EpiIn {
    EPI_COMMON
    bf16_t *QL, *KVL, *KPE, *QB, *KB, *VB, *GATES; float *SSQ, *SSKV; const f32x2* TAB; const float *gqn, *gkn;
    __device__ __forceinline__ void operator()(AccRef acc, const Unit& u, int wr, int wc, int fr, int fq) const {
        const int pn = u.pn, row0 = u.pm * BM + wr * 64 + fr;
        if (pn >= 5) {
#pragma unroll
            for (int ai = 0; ai < 2; ++ai)
#pragma unroll
                for (int m = 0; m < 4; ++m) { bf16_t* rowp = GATES + (size_t)(row0 + ai * HALF + m * 16) * 2048 + (pn - 5) * 256 + wc * 32 + 8 * fq;
#pragma unroll
                    for (int bj = 0; bj < 2; ++bj) *(u32x4*)(rowp + bj * HALF) = pack8(sigmoid4(acc[ai][bj][m][0]), sigmoid4(acc[ai][bj][m][1]));  }
        } else if (pn == 0) {
#pragma unroll
            for (int ai = 0; ai < 2; ++ai)
#pragma unroll
                for (int m = 0; m < 4; ++m) { const int row = row0 + ai * HALF + m * 16; bf16_t* rowp = QL + (size_t)row * 256 + wc * 32 + 8 * fq; float ss = 0.f;
#pragma unroll
                    for (int bj = 0; bj < 2; ++bj) { const f32x4 v0 = acc[ai][bj][m][0], v1 = acc[ai][bj][m][1]; ss += sumsq4(v0) + sumsq4(v1); *(u32x4*)(rowp + bj * HALF) = pack8(v0, v1); }
                    ss = red4x(ss); if (fq == 0) SSQ[(size_t)row * 4 + wc] = ss;  }
        } else if (pn == 1) {
#pragma unroll
            for (int ai = 0; ai < 2; ++ai)
#pragma unroll
                for (int m = 0; m < 4; ++m) { const int row = row0 + ai * HALF + m * 16; bf16_t* rowp = KVL + (size_t)row * 256;
                    { const f32x4 v0 = acc[ai][0][m][0], v1 = acc[ai][0][m][1]; float ss = red4x(sumsq4(v0) + sumsq4(v1)); *(u32x4*)(rowp + wc * 32 + 8 * fq) = pack8(v0, v1); if (fq == 0) SSKV[(size_t)row * 4 + wc] = ss; }
                    const f32x4 x1 = acc[ai][1][m][0], x2 = acc[ai][1][m][1];
                    if (wc == 0) {
                        *(u32x2*)(rowp + 128 + 4 * fq) = pack4(x1); *(u32x2*)(rowp + 128 + 16 + 4 * fq) = pack4(x2);
                        f32x4 o1, o2; rope4(TAB + (size_t)(row & (SEQ - 1)) * 16, fq, x1, x2, o1, o2);
                        *(u32x2*)(KPE + (size_t)row * 32 + 4 * fq) = pack4(o1); *(u32x2*)(KPE + (size_t)row * 32 + 16 + 4 * fq) = pack4(o2);
                    } else *(u32x4*)(rowp + 128 + wc * 32 + 8 * fq) = pack8(x1, x2);
                    }
        } else {
            const bool isv = (pn == 4) && (wc >= 2);
            if (isv) {
#pragma unroll
                for (int ai = 0; ai < 2; ++ai)
#pragma unroll
                    for (int m = 0; m < 4; ++m) { bf16_t* rowp = VB + (size_t)(row0 + ai * HALF + m * 16) * 128 + (wc - 2) * 64 + 4 * fq;
#pragma unroll
                        for (int bj = 0; bj < 2; ++bj)
#pragma unroll
                            for (int n = 0; n < 2; ++n) *(u32x2*)(rowp + 32 * bj + 16 * n) = pack4(acc[ai][bj][m][n]);  }
            } else {
                const bool isk = (pn == 4); const float* g = isk ? gkn : gqn; const float osc = isk ? 1.0f : SCALE_B;
                f32x4 gv[2][2];
#pragma unroll
                for (int bj = 0; bj < 2; ++bj)
#pragma unroll
                    for (int n = 0; n < 2; ++n) gv[bj][n] = *(const f32x4*)(g + 32 * bj + 16 * n + 4 * fq);
#pragma unroll
                for (int ai = 0; ai < 2; ++ai)
#pragma unroll
                    for (int m = 0; m < 4; ++m) { const int row = row0 + ai * HALF + m * 16, t = row & (SEQ - 1);
                        bf16_t* rowp = isk ? KB + (size_t)row * 128 + wc * 64 + 4 * fq : QB + (size_t)row * 512 + (4 * (pn - 2) + wc) * 64 + 4 * fq;
                        float ss = 0.f;
#pragma unroll
                        for (int bj = 0; bj < 2; ++bj) ss += sumsq4(acc[ai][bj][m][0]) + sumsq4(acc[ai][bj][m][1]);
                        const float rs = rsqrt_(red4x(ss) * (1.0f / 64.0f) + EPS);
#pragma unroll
                        for (int bj = 0; bj < 2; ++bj) { const int pos = bj == 0 ? (t >> 6) : (t & 63);
                            f32x4 o1, o2; rope4(TAB + (size_t)pos * 16, fq, acc[ai][bj][m][0] * rs * gv[bj][0], acc[ai][bj][m][1] * rs * gv[bj][1], o1, o2);
                            *(u32x2*)(rowp + 32 * bj) = pack4(o1 * osc); *(u32x2*)(rowp + 32 * bj + 16) = pack4(o2 * osc); }  }
            }
        }
    }
};

struct EpiPle {
    EPI_COMMON
    bf16_t* PP;
    __device__ __forceinline__ void operator()(AccRef acc, const Unit& u, int wr, int wc, int fr, int fq) const {
        const int row0 = u.pm * BM + wr * 64 + fr, col0 = u.pn * BM + wc * 32 + 8 * fq;
#pragma unroll
        for (int ai = 0; ai < 2; ++ai)
#pragma unroll
            for (int m = 0; m < 4; ++m) { bf16_t* rowp = PP + (size_t)(row0 + ai * HALF + m * 16) * D + col0;
#pragma unroll
                for (int bj = 0; bj < 2; ++bj) *(u32x4*)(rowp + bj * HALF) = pack8(acc[ai][bj][m][0], acc[ai][bj][m][1]); }
    }
};

struct EpiLat {
    EPI_COMMON
    bf16_t *QA, *KAN, *VA; const float *SSQ, *SSKV; const f32x2* TAB;
    __device__ __forceinline__ void operator()(AccRef acc, const Unit& u, int wr, int wc, int fr, int fq) const {
        const int pn = u.pn, row0 = u.pm * BM + wr * 64 + fr;
#pragma unroll
        for (int ai = 0; ai < 2; ++ai)
#pragma unroll
            for (int m = 0; m < 4; ++m) { const int row = row0 + ai * HALF + m * 16;
                if (pn < 3) {
                    const f32x4 s4 = *(const f32x4*)(SSQ + (size_t)row * 4); const float rs = rsqrt_(((s4[0] + s4[1]) + (s4[2] + s4[3])) * (1.0f / 256.0f) + EPS) * SCALE_A;
#pragma unroll
                    for (int bj = 0; bj < 2; ++bj) {
                        if (pn < 2) { const int g = 8 * pn + 4 * bj + wc; *(u32x4*)(QA + (size_t)row * 768 + (g >> 1) * 96 + 32 * (g & 1) + 8 * fq) = pack8(acc[ai][bj][m][0] * rs, acc[ai][bj][m][1] * rs); }
                        else { const int h = 4 * bj + wc; f32x4 o1, o2; rope4(TAB + (size_t)(row & (SEQ - 1)) * 16, fq, acc[ai][bj][m][0] * rs, acc[ai][bj][m][1] * rs, o1, o2);
                            bf16_t* p = QA + (size_t)row * 768 + h * 96 + 64 + 4 * fq; *(u32x2*)p = pack4(o1); *(u32x2*)(p + 16) = pack4(o2); } }
                } else {
                    const f32x4 s4 = *(const f32x4*)(SSKV + (size_t)row * 4); const float rs = rsqrt_(((s4[0] + s4[1]) + (s4[2] + s4[3])) * (1.0f / 128.0f) + EPS);
                    bf16_t* base = (pn < 5 ? KAN + (pn - 3) * 256 : VA + (pn - 5) * 256) + (size_t)row * 512 + wc * 32 + 8 * fq;
#pragma unroll
                    for (int bj = 0; bj < 2; ++bj) *(u32x4*)(base + bj * HALF) = pack8(acc[ai][bj][m][0] * rs, acc[ai][bj][m][1] * rs);
                } }
    }
};

struct EpiMerge {
    static constexpr bool PERM = false, AFTER_DRAIN = false;
    const bf16_t* GATES; bf16_t* MG;
    __device__ __forceinline__ bool keep(const Unit& u) const { return u.sel == 0; }
    __device__ __forceinline__ void mid(f32x4 (&acc)[2][2][4][2], const Unit& u, int wr, int wc, int fr, int fq) const {
        const int row0 = u.pm * BM + wr * 64 + fr, col0 = u.pn * BM + wc * 32 + 8 * fq;
#pragma unroll
        for (int ai = 0; ai < 2; ++ai)
#pragma unroll
            for (int m = 0; m < 4; ++m) { const bf16_t* rowp = GATES + (size_t)(row0 + ai * HALF + m * 16) * 2048 + col0;
#pragma unroll
                for (int bj = 0; bj < 2; ++bj) { f32x4 a0, a1, b0, b1; unpack8(*(const u32x4*)(rowp + bj * HALF), a0, a1); unpack8(*(const u32x4*)(rowp + 1024 + bj * HALF), b0, b1);
#pragma unroll
                    for (int i = 0; i < 4; ++i) { acc[ai][bj][m][0][i] *= a0[i] * __builtin_amdgcn_rcpf(b0[i]); acc[ai][bj][m][1][i] *= a1[i] * __builtin_amdgcn_rcpf(b1[i]); } } }
    }
    __device__ __forceinline__ void operator()(AccRef acc, const Unit& u, int wr, int wc, int fr, int fq) const {
        const int row0 = u.pm * BM + wr * 64 + fr, col0 = u.pn * BM + wc * 32 + 8 * fq;
#pragma unroll
        for (int ai = 0; ai < 2; ++ai)
#pragma unroll
            for (int m = 0; m < 4; ++m) { const size_t r = (size_t)(row0 + ai * HALF + m * 16);
#pragma unroll
                for (int bj = 0; bj < 2; ++bj) { f32x4 b0, b1; unpack8(*(const u32x4*)(GATES + r * 2048 + 1024 + col0 + bj * HALF), b0, b1);
                    *(u32x4*)(MG + r * D + col0 + bj * HALF) = pack8(acc[ai][bj][m][0] * b0, acc[ai][bj][m][1] * b1); } }
    }
};

template <bool BASE_BF16> struct EpiRes {
    EPI_COMMON
    const float* basef; bf16_t* XB; float* SS;
    __device__ __forceinline__ void operator()(AccRef acc, const Unit& u, int wr, int wc, int fr, int fq) const {
        const int row0 = u.pm * BM + wr * 64 + fr, col0 = u.pn * BM + wc * 32 + 8 * fq;
#pragma unroll
        for (int ai = 0; ai < 2; ++ai)
#pragma unroll
            for (int m = 0; m < 4; ++m) { const int row = row0 + ai * HALF + m * 16; const size_t off = (size_t)row * D + col0; float ss = 0.f;
#pragma unroll
                for (int bj = 0; bj < 2; ++bj) { f32x4 b0, b1;
                    if (BASE_BF16) unpack8(*(const u32x4*)(XB + off + bj * HALF), b0, b1); else { b0 = *(const f32x4*)(basef + off + bj * HALF); b1 = *(const f32x4*)(basef + off + bj * HALF + 4); }
                    const f32x4 x0 = b0 + acc[ai][bj][m][0], x1 = b1 + acc[ai][bj][m][1];
                    ss += sumsq4(x0) + sumsq4(x1); *(u32x4*)(XB + off + bj * HALF) = pack8(x0, x1); }
                ss = red4x(ss); if (fq == 0) SS[(size_t)row * 16 + 4 * u.pn + wc] = ss; }
    }
};
__device__ __forceinline__ float row_rs16(const float* SS, int row, int fq) {
    const f32x4 a = *(const f32x4*)(SS + (size_t)row * 16 + 4 * fq);
    return rsqrt_(red4x((a[0] + a[1]) + (a[2] + a[3])) * (1.0f / 1024.0f) + EPS);
}
struct EpiUp {
    EPI_COMMON
    const float* SS; bf16_t* U;
    __device__ __forceinline__ void operator()(AccRef acc, const Unit& u, int wr, int wc, int fr, int fq) const {
        const int row0 = u.pm * BM + wr * 64 + fr, col0 = u.pn * BM + wc * 32 + 8 * fq;
#pragma unroll
        for (int ai = 0; ai < 2; ++ai)
#pragma unroll
            for (int m = 0; m < 4; ++m) { const int row = row0 + ai * HALF + m * 16; const float rs = row_rs16(SS, row, fq); bf16_t* rowp = U + (size_t)row * FF + col0;
#pragma unroll
                for (int bj = 0; bj < 2; ++bj) { f32x4 v0 = acc[ai][bj][m][0] * rs, v1 = acc[ai][bj][m][1] * rs;
#pragma unroll
                    for (int i = 0; i < 4; ++i) { v0[i] = fmaxf(v0[i], 0.f); v1[i] = fmaxf(v1[i], 0.f); }
                    *(u32x4*)(rowp + bj * HALF) = pack8(v0 * v0, v1 * v1); } }
    }
};
struct EpiPG {
    EPI_COMMON
    const float* SSin; const bf16_t* PP; const bf16_t* X2; bf16_t* X3; float* SSout;
    __device__ __forceinline__ void operator()(AccRef acc, const Unit& u, int wr, int wc, int fr, int fq) const {
        const int row0 = u.pm * BM + wr * 64 + fr, col0 = u.pn * BM + wc * 32 + 8 * fq;
#pragma unroll
        for (int ai = 0; ai < 2; ++ai)
#pragma unroll
            for (int m = 0; m < 4; ++m) { const int row = row0 + ai * HALF + m * 16; const float rs = row_rs16(SSin, row, fq); const size_t off = (size_t)row * D + col0; float ss = 0.f;
#pragma unroll
                for (int bj = 0; bj < 2; ++bj) { f32x4 p0, p1, b0, b1; unpack8(*(const u32x4*)(PP + off + bj * HALF), p0, p1); unpack8(*(const u32x4*)(X2 + off + bj * HALF), b0, b1);
                    const f32x4 x0 = b0 + sigmoid4(acc[ai][bj][m][0] * rs) * p0, x1 = b1 + sigmoid4(acc[ai][bj][m][1] * rs) * p1;
                    *(u32x4*)(X3 + off + bj * HALF) = pack8(x0, x1); ss += sumsq4(x0) + sumsq4(x1); }
                ss = red4x(ss); if (fq == 0) SSout[(size_t)row * 16 + 4 * u.pn + wc] = ss; }
    }
};
}

namespace att {
constexpr int KBUF = 12288, VBUF = 8192, LDS_K = 0, LDS_V = 2 * KBUF, LDS_WS = 2 * KBUF + 2 * VBUF, LDS_BYTES = LDS_WS + 8 * 256;
constexpr int NT = SEQ / 64;
__device__ __forceinline__ int crow(int r, int hi) { return (r & 3) + 8 * (r >> 2) + 4 * hi; }
__device__ __forceinline__ s16x4 vtr(const LAS unsigned char* p) { typedef short v4i16_t __attribute__((ext_vector_type(4))); return __builtin_bit_cast(s16x4, __builtin_amdgcn_ds_read_tr16_b64_v4i16((LAS v4i16_t*)p)); }

template <int DK>
__device__ __forceinline__ void attn_unit(LAS unsigned char* lds, const bf16_t* Qg, int qpitch, const bf16_t* Kg, int kpitch, const bf16_t* Kpe, const bf16_t* Vg, int vpitch, bf16_t* Og, int opitch) {
    constexpr int ND0 = DK / 16;
    int tid_ = threadIdx.x; asm volatile("" : "+v"(tid_));
    const int tid = tid_, lane = tid & 63, r32 = lane & 31, hi = lane >> 5, wid = __builtin_amdgcn_readfirstlane(tid >> 6);
    LAS float* wsf = (LAS float*)(lds + LDS_WS) + wid * 64;
    const bf16_t* ksrc0 = Kg + (size_t)lane * kpitch + wid * 8;
    const bf16_t* ksrc1 = (DK == 96) ? Kpe + (size_t)lane * 32 + (wid & 3) * 8 : nullptr;
    const bf16_t* vsrc = Vg + (size_t)(16 * (wid & 3) + (lane >> 2)) * vpitch + (wid >> 2) * 32 + (lane & 3) * 8;
#define ATT_ISSUE(t, buf) do { \
        __builtin_amdgcn_global_load_lds((const unsigned*)(ksrc0 + (size_t)(t) * 64 * kpitch), (LAS unsigned*)(lds + LDS_K + (buf) * KBUF + wid * 1024), 16, 0, 0); \
        if (DK == 96 && wid < 4) __builtin_amdgcn_global_load_lds((const unsigned*)(ksrc1 + (size_t)(t) * 64 * 32), (LAS unsigned*)(lds + LDS_K + (buf) * KBUF + (8 + wid) * 1024), 16, 0, 0); \
        __builtin_amdgcn_global_load_lds((const unsigned*)(vsrc + (size_t)(t) * 64 * vpitch), (LAS unsigned*)(lds + LDS_V + (buf) * VBUF + wid * 1024), 16, 0, 0); } while (0)
    ATT_ISSUE(0, 0);
    bf16x8 qr[ND0];
#pragma unroll
    for (int d0 = 0; d0 < ND0; ++d0) qr[d0] = *(const bf16x8*)(Qg + (size_t)(wid * 32 + r32) * qpitch + d0 * 16 + hi * 8);
    f32x16 o0 = {}, o1 = {}, negm = {};
    float mhat = 0.f, lsum = 0.f;
    const int vboff = ((lane >> 4) & 1) * 32 + (lane & 3) * 8 + (4 * hi + ((lane & 15) >> 2)) * 64;
    asm volatile("s_waitcnt vmcnt(0)" ::: "memory"); __syncthreads();
    for (int t = 0; t < NT; ++t) {
        const int buf = t & 1;
        if (t + 1 < NT) ATT_ISSUE(t + 1, buf ^ 1);
        const LAS unsigned char* kb = lds + LDS_K + buf * KBUF + hi * 1024 + r32 * 16;
        f32x16 p0 = negm, p1 = negm;
#pragma unroll
        for (int d0 = 0; d0 < ND0; ++d0) {
            const bf16x8 b0 = *(const LAS bf16x8*)(kb + d0 * 2048), b1 = *(const LAS bf16x8*)(kb + d0 * 2048 + 512);
            p0 = __builtin_amdgcn_mfma_f32_32x32x16_bf16(b0, qr[d0], p0, 0, 0, 0);
            p1 = __builtin_amdgcn_mfma_f32_32x32x16_bf16(b1, qr[d0], p1, 0, 0, 0);
        }
        float rm = fmaxf(p0[0], p1[0]);
#pragma unroll
        for (int r = 1; r < 16; ++r) rm = fmaxf(rm, fmaxf(p0[r], p1[r]));
        rm = fmaxf(rm, __shfl_xor(rm, 32));
        if (t == 0 || __any(rm > 8.0f)) {
            const float dl = (t == 0) ? rm : fmaxf(rm, 0.f);
            mhat += dl;
#pragma unroll
            for (int r = 0; r < 16; ++r) { p0[r] -= dl; p1[r] -= dl; negm[r] = -mhat; }
            if (t != 0) {
                const float f = __builtin_amdgcn_exp2f(-dl); lsum *= f;
                if (hi == 0) wsf[r32] = f;
                asm volatile("s_waitcnt lgkmcnt(0)" ::: "memory");
#pragma unroll
                for (int r = 0; r < 16; ++r) { const float fr_ = wsf[crow(r, hi)]; o0[r] *= fr_; o1[r] *= fr_; }
                asm volatile("s_waitcnt lgkmcnt(0)" ::: "memory");
            }
        }
        float sacc = 0.f;
#pragma unroll
        for (int r = 0; r < 16; ++r) { p0[r] = __builtin_amdgcn_exp2f(p0[r]); p1[r] = __builtin_amdgcn_exp2f(p1[r]); sacc += p0[r] + p1[r]; }
        lsum += sacc;
        u32x4 pw[4];
#pragma unroll
        for (int k = 0; k < 2; ++k)
#pragma unroll
            for (int j = 0; j < 4; ++j) { pw[k][j] = cvt_pk_bf16(p0[8 * k + 2 * j], p0[8 * k + 2 * j + 1]); pw[2 + k][j] = cvt_pk_bf16(p1[8 * k + 2 * j], p1[8 * k + 2 * j + 1]); }
        const LAS unsigned char* vb = lds + LDS_V + buf * VBUF + vboff;
#pragma unroll
        for (int ks = 0; ks < 4; ++ks) {
            const s16x4 l0 = vtr(vb + ks * 1024), h0 = vtr(vb + ks * 1024 + 512), l1 = vtr(vb + 4096 + ks * 1024), h1 = vtr(vb + 4096 + ks * 1024 + 512);
            const bf16x8 v0 = (bf16x8){l0[0], l0[1], l0[2], l0[3], h0[0], h0[1], h0[2], h0[3]}, v1 = (bf16x8){l1[0], l1[1], l1[2], l1[3], h1[0], h1[1], h1[2], h1[3]};
            const bf16x8 pa = __builtin_bit_cast(bf16x8, pw[ks]);
            o0 = __builtin_amdgcn_mfma_f32_32x32x16_bf16(pa, v0, o0, 0, 0, 0);
            o1 = __builtin_amdgcn_mfma_f32_32x32x16_bf16(pa, v1, o1, 0, 0, 0);
        }
        asm volatile("s_waitcnt vmcnt(0)" ::: "memory"); __syncthreads();
    }
#undef ATT_ISSUE
    lsum += __shfl_xor(lsum, 32);
    if (hi == 0) wsf[32 + r32] = lsum;
    asm volatile("s_waitcnt lgkmcnt(0)" ::: "memory");
#pragma unroll
    for (int r = 0; r < 16; ++r) { const int q = crow(r, hi); const float rl = __builtin_amdgcn_rcpf(wsf[32 + q]);
        bf16_t* op = Og + (size_t)(wid * 32 + q) * opitch + r32;
        op[0] = (bf16_t)(cvt_pk_bf16(o0[r] * rl, 0.f) & 0xffffu); op[32] = (bf16_t)(cvt_pk_bf16(o1[r] * rl, 0.f) & 0xffffu); }
    asm volatile("s_waitcnt lgkmcnt(0)" ::: "memory");
}
}

constexpr int NWAVES = 8;
constexpr int RING_BYTES = 131072, LDSCTL_OFF = RING_BYTES, MISC_OFF = LDSCTL_OFF + 320, LDS_BYTES = 147456;

__device__ __forceinline__ float wave_sum(float v) {
#pragma unroll
    for (int o = 1; o < 64; o <<= 1) v += __shfl_xor(v, o);
    return v;
}
__device__ __forceinline__ void map_group(int mat, int g, int& src, bool& perm) {
    perm = true;
    if (mat == 0) {
        if (g < 8) src = 32 * g;
        else if (g < 12) src = 256 + 32 * (g - 8);
        else if (g == 12) { src = 384; perm = false; }
        else if (g < 16) src = -1;
        else if (g < 32) { const int tt = (g - 16) >> 3, gi = (g - 16) & 7, bj = gi >> 2, wc = gi & 3; src = 416 + 64 * (4 * tt + wc) + 32 * bj; perm = false; }
        else if (g < 40) { const int gi = g - 32, bj = gi >> 2, wc = gi & 3; src = (wc < 2 ? 928 + 64 * wc : 1056 + 64 * (wc - 2)) + 32 * bj; perm = false; }
        else src = 1184 + 32 * (g - 40);
    } else if (mat == 1) {
        if (g < 16) src = 96 * (g >> 1) + 32 * (g & 1);
        else { src = 96 * (g - 16) + 64; perm = false; }
    } else if (mat == 2) {
        if (g < 16) src = 128 * (g >> 1) + 32 * (g & 1);
        else src = 128 * ((g - 16) >> 1) + 64 + 32 * ((g - 16) & 1);
    } else src = 32 * g;
}
__device__ __forceinline__ void tr_item(const float* W, int srcN, int srcK, int k0, int src, bool perm, const float* kscale, bf16_t* WT, int Kdst, int destrow0, LAS float* scr, int lane) {
    const bool zero = (src < 0) || (k0 >= srcK);
    if (!zero) {
#pragma unroll
        for (int i = 0; i < 32; ++i) { const int kk = 2 * i + (lane >> 5); float v = W[(size_t)(k0 + kk) * srcN + src + (lane & 31)]; if (kscale) v *= kscale[k0 + kk]; scr[kk * 33 + (lane & 31)] = v; }
    }
    asm volatile("s_waitcnt lgkmcnt(0)" ::: "memory");
    const int c = lane & 7;
#pragma unroll
    for (int j = 0; j < 4; ++j) { const int rho = (lane >> 3) + 8 * j, sidx = perm ? pg8::perm32(rho) : rho; const LAS float* s = scr + (8 * c) * 33 + sidx;
        u32x4 o = {0u, 0u, 0u, 0u};
        if (!zero) { o.x = cvt_pk_bf16(s[0 * 33], s[1 * 33]); o.y = cvt_pk_bf16(s[2 * 33], s[3 * 33]); o.z = cvt_pk_bf16(s[4 * 33], s[5 * 33]); o.w = cvt_pk_bf16(s[6 * 33], s[7 * 33]); }
        *(u32x4*)(WT + (size_t)(destrow0 + rho) * Kdst + k0 + 8 * c) = o; }
    asm volatile("s_waitcnt lgkmcnt(0)" ::: "memory");
}

#ifndef PHASE_MASK
#define PHASE_MASK 0x3ff
#endif
#ifndef REPEAT_MASK
#define REPEAT_MASK 0
#endif
#ifndef USE_CG
#define USE_CG 0
#endif
struct Args { const float* in[20]; float* out; unsigned char* ws; double invf[16]; int rep[16]; };

#ifndef DEBUG_STAGE
#define DEBUG_STAGE -1
#endif
__device__ __noinline__ void dbg_dump(float* out, int ocol, const bf16_t* src, int pitch, int n) {
    for (int row = blockIdx.x; row < T; row += gridDim.x)
        for (int c = threadIdx.x; c < n; c += NWAVES * 64) out[(size_t)row * D + ocol + c] = __uint_as_float((unsigned)src[(size_t)row * pitch + c] << 16);
}
__global__ void __launch_bounds__(NWAVES * 64, 2) fwd_megakernel(Args args) {
    extern __shared__ __attribute__((aligned(16))) unsigned char lds_raw[];
    LAS unsigned char* lds = (LAS unsigned char*)lds_raw;
    const int tid = threadIdx.x;
    const int G = gridDim.x, bx = blockIdx.x, vcu = (G % 8 == 0) ? (bx % 8) * (G / 8) + bx / 8 : bx;
    unsigned char* ws = args.ws;
    for (int u = tid; u < (LDS_BYTES - LDSCTL_OFF) / 4; u += NWAVES * 64) ((LAS unsigned*)(lds + LDSCTL_OFF))[u] = 0u;
    __syncthreads();
#if USE_CG
    cooperative_groups::grid_group cgrid = cooperative_groups::this_grid();
#define GRID_BAR() cgrid.sync()
#else
    XcdBarrier bar = xcd_barrier_post((unsigned*)(ws + WS_CTL) + CW_BAR, (volatile LAS unsigned*)(lds + MISC_OFF) + 8);
#define GRID_BAR() xcd_barrier(bar)
#endif

    const float* x = args.in[0]; const float* p = args.in[1];
    float* out = args.out;
    const f32x2* TAB = (const f32x2*)(ws + WS_TAB);
    const int NGW = G * NWAVES;

#if PHASE_MASK & (1 << 0)
    for (int rep_ = 0; rep_ <= args.rep[0]; ++rep_)
    {
        int t0_ = threadIdx.x; asm volatile("" : "+v"(t0_)); const int tid = t0_, lane = t0_ & 63, wave = __builtin_amdgcn_readfirstlane(t0_ >> 6), gw = vcu * NWAVES + wave;
        LAS float* scr = (LAS float*)(lds + wave * 16384);
        constexpr int NMAT = 10;
        const int srcK[NMAT] = {1024, 256, 128, 512, 512, 1024, 1024, 4096, 1024, 256};
        (void)srcK;
        int it = gw;
#define MAT_ITEMS(KD, NG) (((KD) / 64) * (NG))
        constexpr int I0 = MAT_ITEMS(1024, 104), I1 = MAT_ITEMS(256, 24), I2 = MAT_ITEMS(256, 32), I3 = MAT_ITEMS(512, 32), I4 = I3, I5 = MAT_ITEMS(1024, 32), I6 = MAT_ITEMS(1024, 128),
                      I7 = MAT_ITEMS(4096, 32), I8 = I5, I9 = MAT_ITEMS(256, 32);
        constexpr int NITEMS = I0 + I1 + I2 + I3 + I4 + I5 + I6 + I7 + I8 + I9;
        for (; it < NITEMS; it += NGW) {
            int r = it, mat, sK, sN, Kd, ng; const float* W; const float* ks = nullptr; size_t wo;
            if (r < I0) { mat = 0; sK = 1024; sN = DIN; Kd = 1024; ng = 104; W = args.in[3]; wo = WS_WIN; }
            else if ((r -= I0) < I1) { mat = 1; sK = 256; sN = 768; Kd = 256; ng = 24; W = args.in[5]; ks = args.in[4]; wo = WS_WQB; }
            else if ((r -= I1) < I2) { mat = 2; sK = 128; sN = 1024; Kd = 256; ng = 32; W = args.in[7]; ks = args.in[6]; wo = WS_WKVB; }
            else if ((r -= I2) < I3) { mat = 3; sK = 512; sN = 1024; Kd = 512; ng = 32; W = args.in[10]; wo = WS_WOA; }
            else if ((r -= I3) < I4) { mat = 4; sK = 512; sN = 1024; Kd = 512; ng = 32; W = args.in[11]; wo = WS_WOB; }
            else if ((r -= I4) < I5) { mat = 5; sK = 1024; sN = 1024; Kd = 1024; ng = 32; W = args.in[12]; wo = WS_WO; }
            else if ((r -= I5) < I6) { mat = 6; sK = 1024; sN = 4096; Kd = 1024; ng = 128; W = args.in[14]; ks = args.in[13]; wo = WS_WUP; }
            else if ((r -= I6) < I7) { mat = 7; sK = 4096; sN = 1024; Kd = 4096; ng = 32; W = args.in[15]; wo = WS_WDN; }
            else if ((r -= I7) < I8) { mat = 8; sK = 1024; sN = 1024; Kd = 1024; ng = 32; W = args.in[17]; ks = args.in[16]; wo = WS_WPG; }
            else { r -= I8; mat = 9; sK = 256; sN = 1024; Kd = 256; ng = 32; W = args.in[18]; wo = WS_WPLE; }
            const int kb = r / ng, g = r % ng; int src; bool perm; map_group(mat, g, src, perm);
            tr_item(W, sN, sK, 64 * kb, src, perm, ks, (bf16_t*)(ws + wo), Kd, 32 * g, scr, lane);
        }
#undef MAT_ITEMS
        for (int e = bx * (NWAVES * 64) + tid; e < 2048 * 16; e += G * NWAVES * 64) {
            const int pos = e >> 4, j = e & 15;
            const double a = (double)pos * args.invf[j], rev = a * 0.15915494309189533577, fr = rev - __builtin_rint(rev), th = fr * 6.283185307179586477, t2 = th * th;
            double sc = 1.0, ss = 1.0;
#pragma unroll
            for (int k = 15; k >= 1; --k) { sc = 1.0 - sc * t2 / (double)((2 * k - 1) * (2 * k)); ss = 1.0 - ss * t2 / (double)((2 * k) * (2 * k + 1)); }
            ((f32x2*)(ws + WS_TAB))[e] = (f32x2){(float)sc, (float)(ss * th)};
        }
        { const float* gmix = args.in[2]; bf16_t* H0 = (bf16_t*)(ws + WS_XG);
          f32x4 gv[4];
#pragma unroll
          for (int j = 0; j < 4; ++j) gv[j] = ((const f32x4*)gmix)[lane + 64 * j];
          for (int m0 = gw; m0 < T; m0 += 4 * NGW) {
              f32x4 v[4][4];
#pragma unroll
              for (int r = 0; r < 4; ++r) { const f32x4* xr = (const f32x4*)(x + (size_t)(m0 + r * NGW) * D) + lane;
#pragma unroll
                  for (int j = 0; j < 4; ++j) v[r][j] = xr[64 * j]; }
#pragma unroll
              for (int r = 0; r < 4; ++r) { float s = 0.f;
#pragma unroll
                  for (int j = 0; j < 4; ++j) s += sumsq4(v[r][j]);
                  const float rs = rsqrt_(wave_sum(s) * (1.0f / D) + EPS);
                  u32x2* o8 = (u32x2*)(H0 + (size_t)(m0 + r * NGW) * D) + lane;
#pragma unroll
                  for (int j = 0; j < 4; ++j) o8[64 * j] = pack4(v[r][j] * rs * gv[j]); } } }
        { bf16_t* PB = (bf16_t*)(ws + WS_PB);
          const size_t stride = (size_t)G * NWAVES * 64;
          for (size_t c = (size_t)bx * (NWAVES * 64) + tid; c < (size_t)T * PLE / 8; c += 4 * stride) { f32x4 a[4], b[4];
#pragma unroll
              for (int r = 0; r < 4; ++r) { a[r] = ((const f32x4*)p)[2 * (c + r * stride)]; b[r] = ((const f32x4*)p)[2 * (c + r * stride) + 1]; }
#pragma unroll
              for (int r = 0; r < 4; ++r) ((u32x4*)PB)[c + r * stride] = pack8(a[r], b[r]); } }
    }
#endif
    GRID_BAR();

#if PHASE_MASK & (1 << 1)
    for (int rep_ = 0; rep_ <= args.rep[1]; ++rep_)
    {
        pg8::Gemm g{(const bf16_t*)(ws + WS_PB), nullptr, (const bf16_t*)(ws + WS_WPLE), nullptr, PLE};
        pg8::Order<3> S; S.init(T, D, G, bx);
        pg8::EpiPle E{(bf16_t*)(ws + WS_PP)};
        pg8::gemm_phase<pg8::EpiPle, pg8::Order<3>>(lds, g, S, E);
    }
#endif
#if PHASE_MASK & (1 << 1)
    for (int rep_ = 0; rep_ <= args.rep[1]; ++rep_)
    {
        pg8::Gemm g{(const bf16_t*)(ws + WS_XG), nullptr, (const bf16_t*)(ws + WS_WIN), nullptr, D};
        pg8::Order<0> S; S.init(T, NIN, G, bx);
        pg8::EpiIn E{(bf16_t*)(ws + WS_QL), (bf16_t*)(ws + WS_KVL), (bf16_t*)(ws + WS_KPE), (bf16_t*)(ws + WS_QB), (bf16_t*)(ws + WS_KB), (bf16_t*)(ws + WS_VB), (bf16_t*)(ws + WS_GATES),
                     (float*)(ws + WS_SSQ), (float*)(ws + WS_SSKV), TAB, args.in[8], args.in[9]};
        pg8::gemm_phase<pg8::EpiIn, pg8::Order<0>>(lds, g, S, E);
    }
#endif
    GRID_BAR();

    if (DEBUG_STAGE == 1) { dbg_dump(out, 0, (const bf16_t*)(ws + WS_QB), 512, 512); dbg_dump(out, 512, (const bf16_t*)(ws + WS_KB), 128, 128); dbg_dump(out, 640, (const bf16_t*)(ws + WS_VB), 128, 128); dbg_dump(out, 768, (const bf16_t*)(ws + WS_KPE), 32, 32); dbg_dump(out, 800, (const bf16_t*)(ws + WS_QL), 256, 224); return; }
#if PHASE_MASK & (1 << 2)
    for (int rep_ = 0; rep_ <= args.rep[2]; ++rep_)
    {
        pg8::Gemm g{(const bf16_t*)(ws + WS_QL), (const bf16_t*)(ws + WS_KVL), (const bf16_t*)(ws + WS_WQB), (const bf16_t*)(ws + WS_WKVB), 256};
        pg8::Order<1> S; S.init(T, 7 * 256, G, bx);
        pg8::EpiLat E{(bf16_t*)(ws + WS_QA), (bf16_t*)(ws + WS_KAN), (bf16_t*)(ws + WS_VA), (const float*)(ws + WS_SSQ), (const float*)(ws + WS_SSKV), TAB};
        pg8::gemm_phase<pg8::EpiLat, pg8::Order<1>>(lds, g, S, E);
    }
#endif
    GRID_BAR();

    if (DEBUG_STAGE == 2) { dbg_dump(out, 0, (const bf16_t*)(ws + WS_QA), 768, 768); dbg_dump(out, 768, (const bf16_t*)(ws + WS_KAN), 512, 128); dbg_dump(out, 896, (const bf16_t*)(ws + WS_VA), 512, 128); return; }
#if PHASE_MASK & (1 << 3)
    for (int rep_ = 0; rep_ <= args.rep[3]; ++rep_)
    {
        const bf16_t* QA = (const bf16_t*)(ws + WS_QA); const bf16_t* KAN = (const bf16_t*)(ws + WS_KAN); const bf16_t* VA = (const bf16_t*)(ws + WS_VA); const bf16_t* KPE = (const bf16_t*)(ws + WS_KPE);
        const bf16_t* QB = (const bf16_t*)(ws + WS_QB); const bf16_t* KB = (const bf16_t*)(ws + WS_KB); const bf16_t* VB = (const bf16_t*)(ws + WS_VB);
        bf16_t* OA = (bf16_t*)(ws + WS_OA); bf16_t* OB = (bf16_t*)(ws + WS_OB);
        for (int w = vcu; w < BATCH * 8 * 8; w += G) {
            const int bh = w >> 3, qb = w & 7, b = bh >> 3, h = bh & 7; const size_t row0 = (size_t)b * SEQ + qb * 256, kr0 = (size_t)b * SEQ;
            att::attn_unit<96>(lds, QA + row0 * 768 + h * 96, 768, KAN + kr0 * 512 + h * 64, 512, KPE + kr0 * 32, VA + kr0 * 512 + h * 64, 512, OA + row0 * 512 + h * 64, 512);
        }
        for (int w = vcu; w < BATCH * 8 * 8; w += G) {
            const int grp = w >> 5, within = w & 31, b = grp >> 1, kvh = grp & 1, hq = kvh * 4 + (within >> 3), qb = within & 7; const size_t row0 = (size_t)b * SEQ + qb * 256, kr0 = (size_t)b * SEQ;
            att::attn_unit<64>(lds, QB + row0 * 512 + hq * 64, 512, KB + kr0 * 128 + kvh * 64, 128, nullptr, VB + kr0 * 128 + kvh * 64, 128, OB + row0 * 512 + hq * 64, 512);
        }
    }
#endif
    GRID_BAR();

    if (DEBUG_STAGE == 3) { dbg_dump(out, 0, (const bf16_t*)(ws + WS_OA), 512, 512); dbg_dump(out, 512, (const bf16_t*)(ws + WS_OB), 512, 512); return; }
#if PHASE_MASK & (1 << 4)
    for (int rep_ = 0; rep_ <= args.rep[4]; ++rep_)
    {
        pg8::Gemm g{(const bf16_t*)(ws + WS_OA), (const bf16_t*)(ws + WS_OB), (const bf16_t*)(ws + WS_WOA), (const bf16_t*)(ws + WS_WOB), 512};
        pg8::Order<2> S; S.init(T, D, G, bx);
        pg8::EpiMerge E{(const bf16_t*)(ws + WS_GATES), (bf16_t*)(ws + WS_MG)};
        pg8::gemm_phase<pg8::EpiMerge, pg8::Order<2>>(lds, g, S, E);
    }
#endif
    GRID_BAR();

    if (DEBUG_STAGE == 4) { dbg_dump(out, 0, (const bf16_t*)(ws + WS_MG), 1024, 1024); return; }
#if PHASE_MASK & (1 << 5)
    for (int rep_ = 0; rep_ <= args.rep[5]; ++rep_)
    {
        pg8::Gemm g{(const bf16_t*)(ws + WS_MG), nullptr, (const bf16_t*)(ws + WS_WO), nullptr, D};
        pg8::Order<0> S; S.init(T, D, G, bx);
        pg8::EpiRes<false> E{x, (bf16_t*)(ws + WS_XG), (float*)(ws + WS_SS1)};
        pg8::gemm_phase<pg8::EpiRes<false>, pg8::Order<0>>(lds, g, S, E);
    }
#endif
    GRID_BAR();

    if (DEBUG_STAGE == 5) return;
#if PHASE_MASK & (1 << 6)
    for (int rep_ = 0; rep_ <= args.rep[6]; ++rep_)
    {
        pg8::Gemm g{(const bf16_t*)(ws + WS_XG), nullptr, (const bf16_t*)(ws + WS_WUP), nullptr, D};
        pg8::Order<0> S; S.init(T, FF, G, bx);
        pg8::EpiUp E{(const float*)(ws + WS_SS1), (bf16_t*)(ws + WS_U)};
        pg8::gemm_phase<pg8::EpiUp, pg8::Order<0>>(lds, g, S, E);
    }
#endif
    GRID_BAR();

#if PHASE_MASK & (1 << 7)
    for (int rep_ = 0; rep_ <= args.rep[7]; ++rep_)
    {
        pg8::Gemm g{(const bf16_t*)(ws + WS_U), nullptr, (const bf16_t*)(ws + WS_WDN), nullptr, FF};
        pg8::Order<0> S; S.init(T, D, G, bx);
        pg8::EpiRes<true> E{nullptr, (bf16_t*)(ws + WS_XG), (float*)(ws + WS_SS2)};
        pg8::gemm_phase<pg8::EpiRes<true>, pg8::Order<0>>(lds, g, S, E);
    }
#endif
    GRID_BAR();

    if (DEBUG_STAGE == 7) return;
#if PHASE_MASK & (1 << 8)
    for (int rep_ = 0; rep_ <= args.rep[8]; ++rep_)
    {
        pg8::Gemm g{(const bf16_t*)(ws + WS_XG), nullptr, (const bf16_t*)(ws + WS_WPG), nullptr, D};
        pg8::Order<0> S; S.init(T, D, G, bx);
        pg8::EpiPG E{(const float*)(ws + WS_SS2), (const bf16_t*)(ws + WS_PP), (const bf16_t*)(ws + WS_XG), (bf16_t*)(ws + WS_X3), (float*)(ws + WS_SS3)};
        pg8::gemm_phase<pg8::EpiPG, pg8::Order<0>>(lds, g, S, E);
    }
#endif
    GRID_BAR();

#if PHASE_MASK & (1 << 9)
    for (int rep_ = 0; rep_ <= args.rep[9]; ++rep_)
    {
        int t9 = threadIdx.x; asm volatile("" : "+v"(t9)); const int lane = t9 & 63, gw = vcu * NWAVES + __builtin_amdgcn_readfirstlane(t9 >> 6);
        const float* gf = args.in[19]; const float* SS3 = (const float*)(ws + WS_SS3);
        f32x4 gv[4];
#pragma unroll
        for (int j = 0; j < 4; ++j) gv[j] = ((const f32x4*)gf)[lane + 64 * j];
        const bf16_t* X3 = (const bf16_t*)(ws + WS_X3);
        for (int m0 = gw; m0 < T; m0 += 4 * NGW) {
            u32x2 v[4][4]; f32x4 q4[4];
#pragma unroll
            for (int r = 0; r < 4; ++r) { const int m = m0 + r * NGW; q4[r] = *(const f32x4*)(SS3 + (size_t)m * 16 + 4 * (lane & 3)); const u32x2* xr = (const u32x2*)(X3 + (size_t)m * D) + lane;
#pragma unroll
                for (int j = 0; j < 4; ++j) v[r][j] = xr[64 * j]; }
#pragma unroll
            for (int r = 0; r < 4; ++r) { float qs = (q4[r][0] + q4[r][1]) + (q4[r][2] + q4[r][3]); qs += __shfl_xor(qs, 1); qs += __shfl_xor(qs, 2); const float rs = rsqrt_(qs * (1.0f / 1024.0f) + EPS);
                f32x4* xw = (f32x4*)(out + (size_t)(m0 + r * NGW) * D) + lane;
#pragma unroll
                for (int j = 0; j < 4; ++j) { f32x4 f; f[0] = __uint_as_float(v[r][j].x << 16); f[1] = __uint_as_float(v[r][j].x & 0xffff0000u); f[2] = __uint_as_float(v[r][j].y << 16); f[3] = __uint_as_float(v[r][j].y & 0xffff0000u);
                    xw[64 * j] = f * rs * gv[j]; } } }
    }
#endif
}

extern "C" void kernel_launch(void* const* d_in, const int* in_sizes, int n_in, void* d_out, int out_size, void* d_ws, size_t ws_size, hipStream_t stream) {
    static int grid = 0;
    if (grid == 0) {
        if (n_in != 20 || in_sizes[0] != T * D || out_size != T * D || ws_size < WS_END) { fprintf(stderr, "kernel_launch: unexpected problem shape (n_in %d, in0 %d, out %d, ws %zu); nothing launched\n", n_in, n_in > 0 ? in_sizes[0] : -1, out_size, ws_size); grid = -1; return; }
        int dev = 0, cus = 0;
        if (hipGetDevice(&dev) != hipSuccess || hipDeviceGetAttribute(&cus, hipDeviceAttributeMultiprocessorCount, dev) != hipSuccess) { grid = -1; return; }
        if (hipFuncSetAttribute((const void*)fwd_megakernel, hipFuncAttributeMaxDynamicSharedMemorySize, LDS_BYTES) != hipSuccess) { fprintf(stderr, "kernel_launch: hipFuncSetAttribute failed\n"); grid = -1; return; }
        grid = cus;
    }
    if (grid < 0) return;
    (void)hipMemsetAsync((char*)d_ws + WS_CTL, 0, CTL_ZERO_BYTES, stream);
    Args a{};
    for (int i = 0; i < 20; ++i) a.in[i] = (const float*)d_in[i];
    a.out = (float*)d_out; a.ws = (unsigned char*)d_ws;
    for (int j = 0; j < 16; ++j) a.invf[j] = std::pow(10000.0, -(double)j / 16.0);
    for (int j = 0; j < 16; ++j) a.rep[j] = (REPEAT_MASK >> j) & 1;
#if USE_CG
    void* kargs[] = {&a};
    (void)hipLaunchCooperativeKernel((const void*)fwd_megakernel, dim3(grid), dim3(NWAVES * 64), kargs, LDS_BYTES, stream);
#else
    hipLaunchKernelGGL(fwd_megakernel, dim3(grid), dim3(NWAVES * 64), LDS_BYTES, stream, a);
#endif
}
```
